# Optimizing an MI355X kernel written in HIP

```python
import jax, jax.numpy as jnp
from jax import lax
import numpy as np

D_MODEL = 1024
BATCH = 8
SEQ = 2048
DEPTH = 2
DEC_BATCH = 128
DEC_SEQ = 8
PAST_LEN = 16384
PAGE_SIZE = 128

N_MIXERS = 2
N_CONV_LAYERS = (DEPTH + 1) // 2
N_GDN_LAYERS = DEPTH // 2
D_CONV = D_MODEL
CONV_A_WIDTH = 3
GDN_HEADS = 8
GDN_DK = 128
GDN_DV = 128
GDN_QK = GDN_HEADS * GDN_DK
GDN_VW = GDN_HEADS * GDN_DV
GDN_CONV_CH = 2 * GDN_QK + GDN_VW
GDN_CONV_WIDTH = 4
GDN_IN = GDN_CONV_CH + GDN_VW + 2 * GDN_HEADS
GDN_CHUNK = 64
ALPHA = (2 * DEPTH) ** 0.25
BETA_INIT = (8 * DEPTH) ** -0.25
LN_EPS = 1e-5
NORM_EPS = 1e-6

kernel_name = 'hybrid_shortconv_gdn_adaln_deepnorm_step'


def causal_dwconv(x, buf, w):
    width = w.shape[0]
    T = x.shape[1]
    xp = jnp.concatenate([buf.astype(x.dtype), x], axis=1)
    y = xp[:, 0:T] * w[0]
    for j in range(1, width):
        y = y + xp[:, j:j + T] * w[j]
    return y, xp[:, T:]


def layer_norm(x, g, b):
    xf = x.astype(jnp.float32)
    mu = jnp.mean(xf, axis=-1, keepdims=True)
    var = jnp.mean(jnp.square(xf - mu), axis=-1, keepdims=True)
    return ((xf - mu) * lax.rsqrt(var + LN_EPS) * g.astype(jnp.float32) + b.astype(jnp.float32)).astype(x.dtype)


def l2norm(x):
    return x * lax.rsqrt(jnp.sum(x * x, axis=-1, keepdims=True) + NORM_EPS)


def gated_delta_rule(q, k, v, g, beta, s0):
    bsz, T, H, dk = q.shape
    dv = v.shape[-1]
    C = min(GDN_CHUNK, T)
    n = -(-T // C)
    pad = n * C - T

    def prep(t):
        t = jnp.pad(t, [(0, 0), (0, pad)] + [(0, 0)] * (t.ndim - 2))
        t = t.reshape((bsz, n, C) + t.shape[2:])
        return jnp.moveaxis(t, 3, 1)

    q, k, v, g, beta = [prep(t) for t in (q * dk ** -0.5, k, v, g, beta)]
    G = jnp.cumsum(g, axis=-1)
    idx = jnp.arange(C)
    causal = idx[:, None] >= idx[None, :]
    strict = idx[:, None] > idx[None, :]
    diff = G[..., :, None] - G[..., None, :]
    L = jnp.where(causal, jnp.exp(jnp.where(causal, diff, 0.0)), 0.0)
    kb = k * beta[..., None]
    A = jnp.where(strict, jnp.einsum('bhnid,bhnjd->bhnij', kb, k) * L, 0.0)
    IA = A + jnp.eye(C, dtype=A.dtype)
    rhs = jnp.concatenate([v * beta[..., None], kb * jnp.exp(G)[..., None]], axis=-1)
    sol = lax.linalg.triangular_solve(IA, rhs, left_side=True, lower=True, unit_diagonal=True)
    u, w = sol[..., :dv], sol[..., dv:]
    attn = jnp.einsum('bhnid,bhnjd->bhnij', q, k) * L
    qg = q * jnp.exp(G)[..., None]
    kt = k * jnp.exp(G[..., -1:] - G)[..., None]
    gl = jnp.exp(G[..., -1])
    xs = tuple(jnp.moveaxis(t, 2, 0) for t in (u, w, qg, attn, kt, gl))

    def step(S, inp):
        u_c, w_c, qg_c, attn_c, kt_c, gl_c = inp
        v_new = u_c - jnp.einsum('bhck,bhkv->bhcv', w_c, S)
        o = jnp.einsum('bhck,bhkv->bhcv', qg_c, S) + jnp.einsum('bhij,bhjv->bhiv', attn_c, v_new)
        S = S * gl_c[..., None, None] + jnp.einsum('bhck,bhcv->bhkv', kt_c, v_new)
        return S, o

    S, o = lax.scan(step, s0, xs)
    o = jnp.transpose(o, (1, 0, 3, 2, 4)).reshape(bsz, n * C, H, dv)[:, :T]
    return o, S


def short_conv_mixer(u, buf, w_in, w_conv, w_out):
    p = u @ w_in
    b_gate = p[..., :D_CONV]
    c_gate = p[..., D_CONV:2 * D_CONV]
    h = p[..., 2 * D_CONV:3 * D_CONV]
    z = p[..., 3 * D_CONV:]
    y, new_buf = causal_dwconv(c_gate * h, buf, w_conv)
    return (b_gate * y * jax.nn.silu(z)) @ w_out, new_buf


def gdn_mixer(u, conv_buf, s0, w_in, w_conv, a_log, dt_bias, norm_w, w_out):
    f32 = jnp.float32
    bsz, T, _ = u.shape
    p = u @ w_in
    qkv, new_buf = causal_dwconv(p[..., :GDN_CONV_CH], conv_buf, w_conv)
    qkv = jax.nn.silu(qkv).astype(f32)
    z = p[..., GDN_CONV_CH:GDN_CONV_CH + GDN_VW]
    b = p[..., GDN_CONV_CH + GDN_VW:GDN_CONV_CH + GDN_VW + GDN_HEADS].astype(f32)
    a = p[..., GDN_CONV_CH + GDN_VW + GDN_HEADS:].astype(f32)
    q = l2norm(qkv[..., :GDN_QK].reshape(bsz, T, GDN_HEADS, GDN_DK))
    k = l2norm(qkv[..., GDN_QK:2 * GDN_QK].reshape(bsz, T, GDN_HEADS, GDN_DK))
    v = qkv[..., 2 * GDN_QK:].reshape(bsz, T, GDN_HEADS, GDN_DV)
    beta = jax.nn.sigmoid(b)
    g = -jnp.exp(a_log.astype(f32)) * jax.nn.softplus(a + dt_bias.astype(f32))
    o, S = gated_delta_rule(q, k, v, g, beta, s0.astype(f32))
    o = o * lax.rsqrt(jnp.mean(o * o, axis=-1, keepdims=True) + NORM_EPS) * norm_w.astype(f32)
    o = o.reshape(bsz, T, GDN_VW).astype(u.dtype) * jax.nn.silu(z)
    return o @ w_out, new_buf, S.astype(s0.dtype)


def trunk(x, c, conv_a, conv_b, ssm_b, w_mod, b_mod, ln_g, ln_b, wa_in, wa_conv, wa_out,
          wb_in, wb_conv, wb_a_log, wb_dt_bias, wb_norm, wb_out):
    new_a, new_cb, new_s = [], [], []
    cs = jax.nn.silu(c)
    for l in range(DEPTH):
        mod = cs @ w_mod[l] + b_mod[l]
        shift = mod[:, None, :D_MODEL]
        scale = mod[:, None, D_MODEL:2 * D_MODEL]
        gate = mod[:, None, 2 * D_MODEL:]
        u = x * (1.0 + scale) + shift
        i = l // N_MIXERS
        if l % N_MIXERS == 0:
            out, nb = short_conv_mixer(u, conv_a[i], wa_in[i], wa_conv[i], wa_out[i])
            new_a.append(nb)
        else:
            out, nb, S = gdn_mixer(u, conv_b[i], ssm_b[i], wb_in[i], wb_conv[i], wb_a_log[i],
                                   wb_dt_bias[i], wb_norm[i], wb_out[i])
            new_cb.append(nb)
            new_s.append(S)
        x = layer_norm(ALPHA * x + gate * out, ln_g[l], ln_b[l])
    return x, jnp.stack(new_a), jnp.stack(new_cb), jnp.stack(new_s)


def setup_inputs(seed: int = 0) -> dict:
    key = jax.random.key(seed)
    ks = jax.random.split(key, 24)
    nrm = lambda k, s, sc: jax.random.normal(k, s, jnp.float32) * sc
    dt = jnp.exp(jax.random.uniform(ks[18], (N_GDN_LAYERS, GDN_HEADS), jnp.float32, np.log(1e-3), np.log(1e-1)))
    return {
        'x_prompt': nrm(ks[0], (BATCH, SEQ, D_MODEL), 1.0),
        'x_sample': nrm(ks[1], (DEC_BATCH, DEC_SEQ, D_MODEL), 1.0),
        'state_conv_a': nrm(ks[2], (N_CONV_LAYERS, DEC_BATCH, CONV_A_WIDTH - 1, D_CONV), 0.5),
        'state_conv_b': nrm(ks[3], (N_GDN_LAYERS, DEC_BATCH, GDN_CONV_WIDTH - 1, GDN_CONV_CH), 1.0),
        'state_ssm_b': nrm(ks[4], (N_GDN_LAYERS, DEC_BATCH, GDN_HEADS, GDN_DK, GDN_DV), 0.1),
        'c_prompt': nrm(ks[5], (BATCH, D_MODEL), 1.0),
        'c_sample': nrm(ks[6], (DEC_BATCH, D_MODEL), 1.0),
        'w_mod': nrm(ks[7], (DEPTH, D_MODEL, 3 * D_MODEL), 0.5 * D_MODEL ** -0.5),
        'b_mod': nrm(ks[8], (DEPTH, 3 * D_MODEL), 0.01),
        'ln_g': 1.0 + nrm(ks[9], (DEPTH, D_MODEL), 0.02),
        'ln_b': nrm(ks[10], (DEPTH, D_MODEL), 0.02),
        'wa_in': nrm(ks[11], (N_CONV_LAYERS, D_MODEL, 4 * D_CONV), D_MODEL ** -0.5),
        'wa_conv': nrm(ks[12], (N_CONV_LAYERS, CONV_A_WIDTH, D_CONV), CONV_A_WIDTH ** -0.5),
        'wa_out': nrm(ks[13], (N_CONV_LAYERS, D_CONV, D_MODEL), BETA_INIT * D_CONV ** -0.5),
        'wb_in': nrm(ks[14], (N_GDN_LAYERS, D_MODEL, GDN_IN), D_MODEL ** -0.5),
        'wb_conv': nrm(ks[15], (N_GDN_LAYERS, GDN_CONV_WIDTH, GDN_CONV_CH), GDN_CONV_WIDTH ** -0.5),
        'wb_a_log': jnp.log(jax.random.uniform(ks[16], (N_GDN_LAYERS, GDN_HEADS), jnp.float32, 1.0, 16.0)),
        'wb_dt_bias': dt + jnp.log(-jnp.expm1(-dt)),
        'wb_norm': 1.0 + nrm(ks[17], (N_GDN_LAYERS, GDN_DV), 0.02),
        'wb_out': nrm(ks[19], (N_GDN_LAYERS, GDN_VW, D_MODEL), BETA_INIT * GDN_VW ** -0.5),
    }


def reference(x_prompt, x_sample, state_conv_a, state_conv_b, state_ssm_b, c_prompt, c_sample,
              w_mod, b_mod, ln_g, ln_b, wa_in, wa_conv, wa_out,
              wb_in, wb_conv, wb_a_log, wb_dt_bias, wb_norm, wb_out):
    bp = x_prompt.shape[0]
    dt_ = x_prompt.dtype
    zero_a = jnp.zeros((N_CONV_LAYERS, bp, CONV_A_WIDTH - 1, D_CONV), dt_)
    zero_cb = jnp.zeros((N_GDN_LAYERS, bp, GDN_CONV_WIDTH - 1, GDN_CONV_CH), dt_)
    zero_s = jnp.zeros((N_GDN_LAYERS, bp, GDN_HEADS, GDN_DK, GDN_DV), state_ssm_b.dtype)
    y_prompt, conv_a_p, conv_b_p, ssm_b_p = trunk(
        x_prompt, c_prompt, zero_a, zero_cb, zero_s, w_mod, b_mod, ln_g, ln_b, wa_in, wa_conv, wa_out,
        wb_in, wb_conv, wb_a_log, wb_dt_bias, wb_norm, wb_out)
    y_sample, conv_a_s, conv_b_s, ssm_b_s = trunk(
        x_sample, c_sample, state_conv_a, state_conv_b, state_ssm_b, w_mod, b_mod, ln_g, ln_b,
        wa_in, wa_conv, wa_out, wb_in, wb_conv, wb_a_log, wb_dt_bias, wb_norm, wb_out)
    return (y_prompt, y_sample, conv_a_p, conv_b_p, ssm_b_p, conv_a_s, conv_b_s, ssm_b_s)
```

```cpp
#include <hip/hip_runtime.h>
#include <hip/hip_cooperative_groups.h>
#include <cstdio>
namespace cg = cooperative_groups;

typedef unsigned short bf16_t;
typedef short bf16x8 __attribute__((ext_vector_type(8)));
typedef float f32x16 __attribute__((ext_vector_type(16)));
typedef float f32x4 __attribute__((ext_vector_type(4)));
typedef unsigned u32x4 __attribute__((ext_vector_type(4)));
typedef unsigned u32x2 __attribute__((ext_vector_type(2)));

#define DI __device__ __forceinline__
#define MFMA32(a, b, c) __builtin_amdgcn_mfma_f32_32x32x16_bf16((a), (b), (c), 0, 0, 0)

constexpr int MTOT = 17408, MP = 16384;
constexpr size_t MiB = 1ull << 20;
constexpr size_t WS_WT1 = 0, WS_WT2 = 8 * MiB, WS_WT3 = 10 * MiB, WS_WT4 = 19 * MiB, WS_MOD = 21 * MiB, WS_STATS = 25 * MiB,
                 WS_BA = 25 * MiB + 512 * 1024, WS_GL = 26 * MiB + 768 * 1024, WS_BAR = 26 * MiB + 832 * 1024, WS_CST = 24 * MiB + 256 * 1024, WS_ABUF = 27 * MiB, WS_CH = 61 * MiB, WS_G1 = 95 * MiB,
                 WS_QKV = 129 * MiB, WS_ATTN = 231 * MiB;
constexpr size_t WS_U = WS_ABUF, WS_Z = WS_CH, WS_W = WS_G1, WS_O = WS_QKV;
constexpr size_t OUT_Y = 0, OUT_CAP = 17825792, OUT_CBP = 17842176, OUT_SSP = 17915904, OUT_CAS = 18964480, OUT_CBS = 19226624, OUT_SSS = 20406272;
constexpr int LDS_BYTES = 72192;
constexpr float ALPHA_F = 1.41421356237309515f;

struct Params {
  const float *x_p, *x_s, *st_conv_a, *st_conv_b, *st_ssm, *c_p, *c_s, *w_mod, *b_mod, *ln_g, *ln_b, *wa_in, *wa_conv, *wa_out, *wb_in, *wb_conv,
      *wb_a_log, *wb_dt_bias, *wb_norm, *wb_out;
  float* out;
  char* ws;
};

typedef float f32x2v __attribute__((ext_vector_type(2)));
typedef __bf16 bf16x2v __attribute__((ext_vector_type(2)));
DI unsigned pk2(float lo, float hi) { f32x2v v = {lo, hi}; bf16x2v b = __builtin_convertvector(v, bf16x2v); return __builtin_bit_cast(unsigned, b); }
DI unsigned f2bf(float x) { __bf16 b = (__bf16)x; return (unsigned)__builtin_bit_cast(unsigned short, b); }
DI float bflo(unsigned u) { return __uint_as_float(u << 16); }
DI float bfhi(unsigned u) { return __uint_as_float(u & 0xffff0000u); }
DI float bf2f(bf16_t v) { return __uint_as_float(((unsigned)v) << 16); }
DI float silu(float x) { return x * __builtin_amdgcn_rcpf(1.f + __expf(-x)); }
DI int otid() { int t = threadIdx.x; asm volatile("" : "+v"(t)); return t; }
DI int rowi(int i, int lane) { return (i & 3) + 8 * (i >> 2) + 4 * (lane >> 5); }
DI int bidx(int row) { return row < MP ? (row >> 11) : 8 + ((row - MP) >> 3); }
DI const float* xrow(const Params& p, int row) { return row < MP ? p.x_p + (size_t)row * 1024 : p.x_s + (size_t)(row - MP) * 1024; }
DI bf16x8 pack8(const f32x16& x, int s) {
  u32x4 r;
  r[0] = pk2(x[8 * s + 0], x[8 * s + 1]); r[1] = pk2(x[8 * s + 2], x[8 * s + 3]); r[2] = pk2(x[8 * s + 4], x[8 * s + 5]); r[3] = pk2(x[8 * s + 6], x[8 * s + 7]);
  return __builtin_bit_cast(bf16x8, r);
}


#define XB_TMO      128
#define XB_XCNT(j)  (256  + 64 * (j))
#define XB_XSUB(j)  (1280 + 64 * (j))
#define XB_XGEN(j)  (2304 + 64 * (j))
#define XB_TOP      3328
#define XB_TOPGEN   3392
#define XCD_BAR_WORDS 3456
#define XB_SPIN_CAP (1u << 18)
#define LAS __attribute__((address_space(3)))
DI unsigned xb_ld(unsigned* p) { return __hip_atomic_load(p, __ATOMIC_RELAXED, __HIP_MEMORY_SCOPE_AGENT); }
DI unsigned xb_add(unsigned* p, unsigned v) { return __hip_atomic_fetch_add(p, v, __ATOMIC_RELAXED, __HIP_MEMORY_SCOPE_AGENT); }
DI unsigned xb_xcc_id() { return (unsigned)__builtin_amdgcn_s_getreg((3 << 11) | 20) & 0xFu; }
#define XB_SPIN(cond, bar) do { unsigned _sp = 0; while (cond) { __builtin_amdgcn_s_sleep(1); \
    if ((++_sp & 255u) == 0u) { if (xb_ld(&(bar)[XB_TMO])) break; if (_sp > XB_SPIN_CAP) { atomicAdd(&(bar)[XB_TMO], 1u); break; } } } } while (0)
struct XcdBarrier { unsigned* bar; unsigned x; volatile LAS unsigned* st; };
DI XcdBarrier xcd_barrier_post(unsigned* bar, volatile LAS unsigned* st) {
  XcdBarrier b; b.bar = bar; b.x = xb_xcc_id(); b.st = st;
  if (threadIdx.x == 0) (void)xb_add(&bar[XB_XCNT(b.x)], 1u);
  return b;
}
DI void xcd_barrier_complete(unsigned* bar, unsigned x, unsigned& nloc, unsigned& nx) {
  const unsigned G = gridDim.x * gridDim.y * gridDim.z;
  unsigned sum, cnt, mine, sp = 0u;
  for (;;) {
    sum = 0u; cnt = 0u; mine = 0u;
#pragma unroll
    for (unsigned j = 0; j < 16; ++j) { const unsigned c = xb_ld(&bar[XB_XCNT(j)]); sum += c; cnt += (c > 0u) ? 1u : 0u; mine = (j == x) ? c : mine; }
    if (sum == G) break;
    __builtin_amdgcn_s_sleep(1);
    if ((++sp & 255u) == 0u) { if (xb_ld(&bar[XB_TMO])) break; if (sp > XB_SPIN_CAP) { atomicAdd(&bar[XB_TMO], 1u); break; } }
  }
  nloc = mine > 0u ? mine : 1u; nx = cnt > 0u ? cnt : 1u;
}
DI void xcd_barrier(const XcdBarrier& b) {
  asm volatile("s_waitcnt vmcnt(0)" ::: "memory");
  __syncthreads();
  if (threadIdx.x == 0) {
    unsigned* bar = b.bar;
    __builtin_amdgcn_s_waitcnt(0);
    unsigned nloc = b.st[0], nx = b.st[1];
    if (nloc == 0u) { xcd_barrier_complete(bar, b.x, nloc, nx); b.st[0] = nloc; b.st[1] = nx; }
    const unsigned old = xb_add(&bar[XB_XSUB(b.x)], 1u);
    const unsigned gen = old / nloc;
    if (old + 1u == (gen + 1u) * nloc) {
      __builtin_amdgcn_fence(__ATOMIC_RELEASE, "agent");
      asm volatile("s_waitcnt vmcnt(0)" ::: "memory");
      const unsigned og = xb_add(&bar[XB_TOP], 1u);
      const unsigned tg = og / nx;
      if (og + 1u == (tg + 1u) * nx) xb_add(&bar[XB_TOPGEN], 1u);
      else XB_SPIN(xb_ld(&bar[XB_TOPGEN]) == tg, bar);
      __builtin_amdgcn_fence(__ATOMIC_ACQUIRE, "agent");
      xb_add(&bar[XB_XGEN(b.x)], 1u);
      asm volatile("s_waitcnt vmcnt(0)" ::: "memory");
    } else {
      XB_SPIN(xb_ld(&bar[XB_XGEN(b.x)]) == gen, bar);
      __builtin_amdgcn_fence(__ATOMIC_ACQUIRE, "agent");
      asm volatile("s_waitcnt vmcnt(0)" ::: "memory");
    }
  }
  __syncthreads();
}
DI void lds_barrier() { asm volatile("s_waitcnt lgkmcnt(0)\n\ts_barrier" ::: "memory"); }

DI void phase0a(const Params& p) {
  float* CST = (float*)(p.ws + WS_CST);
  for (int idx = blockIdx.x * 256 + otid(); idx < 1024 * 160; idx += gridDim.x * 256) {
    const int k = idx / 160, r = idx - k * 160;
    float v = 0.f;
    if (r < 8) v = silu(p.c_p[r * 1024 + k]); else if (r < 136) v = silu(p.c_s[(r - 8) * 1024 + k]);
    CST[idx] = v;
  }
}
DI void phase0(const Params& p, char* smem) {
  float* MOD = (float*)(p.ws + WS_MOD);
  const float* CST = (const float*)(p.ws + WS_CST);
  const int nmod = gridDim.x >= 384 ? 192 : 0;
  const int tstep = gridDim.x - nmod;
  if (nmod == 0 || (int)blockIdx.x < nmod)
  for (int task = blockIdx.x; task < 192; task += gridDim.x) {
    int tid = threadIdx.x; asm volatile("" : "+v"(tid));
    {
      const int l = task / 96, cb = task % 96;
      const int lane = tid & 63, wave = tid >> 6;
      float* red = (float*)smem;
      __syncthreads();
      for (int i = tid; i < 160 * 32; i += 256) red[i] = 0.f;
      __syncthreads();
      f32x16 acc[5];
#pragma unroll
      for (int mt = 0; mt < 5; ++mt)
#pragma unroll
        for (int i = 0; i < 16; ++i) acc[mt][i] = 0.f;
      const float* wm = p.w_mod + (size_t)l * 1024 * 3072 + cb * 32 + (lane & 31) + (size_t)(wave * 256 + (lane >> 5)) * 3072;
      const float* ct = CST + (lane & 31) + (wave * 256 + (lane >> 5)) * 160;
      float bA[8], aA[8][5], bB[8], aB[8][5];
#define MOD_LOAD(bb, aa, g) { _Pragma("unroll") for (int u = 0; u < 8; ++u) { const int kk = 2 * ((g) * 8 + u); bb[u] = wm[(size_t)kk * 3072]; _Pragma("unroll") for (int mt = 0; mt < 5; ++mt) aa[u][mt] = ct[kk * 160 + mt * 32]; } }
#define MOD_COMP(bb, aa) { _Pragma("unroll") for (int u = 0; u < 8; ++u) { _Pragma("unroll") for (int mt = 0; mt < 5; ++mt) acc[mt] = __builtin_amdgcn_mfma_f32_32x32x2f32(aa[u][mt], bb[u], acc[mt], 0, 0, 0); } }
      MOD_LOAD(bA, aA, 0);
#pragma unroll 1
      for (int g = 0; g < 16; g += 2) {
        MOD_LOAD(bB, aB, g + 1);
        MOD_COMP(bA, aA);
        { const int g2 = g + 2 < 16 ? g + 2 : 15; MOD_LOAD(bA, aA, g2); }
        MOD_COMP(bB, aB);
      }
#pragma unroll
      for (int mt = 0; mt < 5; ++mt)
#pragma unroll
        for (int i = 0; i < 16; ++i) atomicAdd(&red[(mt * 32 + rowi(i, lane)) * 32 + (lane & 31)], acc[mt][i]);
      __syncthreads();
      {
        const int col = tid & 31;
        const float bm = p.b_mod[l * 3072 + cb * 32 + col];
        for (int r = tid >> 5; r < 136; r += 8) MOD[((size_t)l * 136 + r) * 3072 + cb * 32 + col] = red[r * 32 + col] + bm;
      }
    }
  }
  if ((int)blockIdx.x >= nmod) {
    {
      const int tid = threadIdx.x;
      const int TOT = (4096 + 1024 + 4224 + 1024) * 128;
      const int nthr = tstep * 256;
      for (int it0 = ((int)blockIdx.x - nmod) * 256 + tid; it0 < TOT; it0 += 2 * nthr) {
        float v[2][8]; bf16_t* dptr[2]; bool ok[2];
#pragma unroll
        for (int u = 0; u < 2; ++u) {
          int it = it0 + u * nthr; ok[u] = it < TOT; if (!ok[u]) it = it0;
          const float* src; int ldw, N, mode; bf16_t* dst;
          if (it < 4096 * 128) { src = p.wa_in; ldw = 4096; N = 4096; mode = 1; dst = (bf16_t*)(p.ws + WS_WT1); }
          else if (it < 5120 * 128) { it -= 4096 * 128; src = p.wa_out; ldw = 1024; N = 1024; mode = 0; dst = (bf16_t*)(p.ws + WS_WT2); }
          else if (it < 9344 * 128) { it -= 5120 * 128; src = p.wb_in; ldw = 4112; N = 4224; mode = 2; dst = (bf16_t*)(p.ws + WS_WT3); }
          else { it -= 9344 * 128; src = p.wb_out; ldw = 1024; N = 1024; mode = 0; dst = (bf16_t*)(p.ws + WS_WT4); }
          const int k8 = it / N, np = it - k8 * N;
          int sc = np;
          if (mode == 1) { const int nt128 = np >> 7, seg = (np >> 5) & 3, j = np & 31; sc = (seg == 0 ? 1024 : seg == 1 ? 2048 : seg == 2 ? 0 : 3072) + nt128 * 32 + j; }
          const bool valid = !(mode == 2 && np >= 4112);
          const float* sp = src + (size_t)(k8 * 8) * ldw + (valid ? sc : 0);
#pragma unroll
          for (int j = 0; j < 8; ++j) { const float x = sp[(size_t)j * ldw]; v[u][j] = valid ? x : 0.f; }
          dptr[u] = dst + ((size_t)((np >> 5) * 64 + (k8 >> 1)) * 64 + (np & 31) + 32 * (k8 & 1)) * 8;
        }
#pragma unroll
        for (int u = 0; u < 2; ++u) if (ok[u]) {
          u32x4 o; o[0] = pk2(v[u][0], v[u][1]); o[1] = pk2(v[u][2], v[u][3]); o[2] = pk2(v[u][4], v[u][5]); o[3] = pk2(v[u][6], v[u][7]);
          *(u32x4*)dptr[u] = o;
        }
      }
    }
  }
}

DI void phase1(const Params& p) {
  const float* MOD = (const float*)(p.ws + WS_MOD);
  bf16_t* AB = (bf16_t*)(p.ws + WS_ABUF);
  for (int i = blockIdx.x * 256 + otid(); i < MTOT * 128; i += gridDim.x * 256) {
    const int row = i >> 7, c8 = (i & 127) * 8;
    const float* xr = xrow(p, row) + c8;
    const float* md = MOD + (size_t)bidx(row) * 3072 + c8;
    const f32x4 x0 = *(const f32x4*)xr, x1 = *(const f32x4*)(xr + 4);
    const f32x4 sh0 = *(const f32x4*)md, sh1 = *(const f32x4*)(md + 4), sc0 = *(const f32x4*)(md + 1024), sc1 = *(const f32x4*)(md + 1028);
    u32x4 o;
    o[0] = pk2(x0[0] * (1.f + sc0[0]) + sh0[0], x0[1] * (1.f + sc0[1]) + sh0[1]);
    o[1] = pk2(x0[2] * (1.f + sc0[2]) + sh0[2], x0[3] * (1.f + sc0[3]) + sh0[3]);
    o[2] = pk2(x1[0] * (1.f + sc1[0]) + sh1[0], x1[1] * (1.f + sc1[1]) + sh1[1]);
    o[3] = pk2(x1[2] * (1.f + sc1[2]) + sh1[2], x1[3] * (1.f + sc1[3]) + sh1[3]);
    *(u32x4*)(AB + (size_t)row * 1024 + c8) = o;
  }
}

template <int MI, class Epi>
DI void gemm_phase(const bf16_t* __restrict__ A, const bf16_t* __restrict__ Bt, const int ntN, char* smem, const Epi& epi) {
  constexpr int BM = 64 * MI;
  bf16_t* sA = (bf16_t*)smem;
  const int ntiles = (MTOT / BM) * ntN;
  for (int t = blockIdx.x; t < ntiles; t += gridDim.x) {
    const int tid = otid(), lane = tid & 63, wave = tid >> 6, wr = wave >> 1, wc = wave & 1;
    const int lrow = tid >> 3, lkc = (tid & 7) * 8;
    const int mt = t / ntN, nt = t - mt * ntN;
    const bf16_t* Ag = A + ((size_t)mt * BM + lrow) * 1024 + lkc;
    const bf16_t* Bf = Bt + (size_t)(nt * 4 + wc * 2) * 64 * 512 + lane * 8;
    f32x16 acc[MI][2];
#pragma unroll
    for (int mi = 0; mi < MI; ++mi)
#pragma unroll
      for (int nj = 0; nj < 2; ++nj)
#pragma unroll
        for (int i = 0; i < 16; ++i) acc[mi][nj][i] = 0.f;
    typename Epi::Pre pre;
    epi.prefetch(mt * BM + wr * (32 * MI), nt, wc, lane, pre);
    u32x4 ra[2 * MI];
    bf16x8 bfr[2][4];
#pragma unroll
    for (int q = 0; q < 2 * MI; ++q) ra[q] = *(const u32x4*)(Ag + (size_t)q * 32 * 1024);
#pragma unroll
    for (int nj = 0; nj < 2; ++nj)
#pragma unroll
      for (int ks = 0; ks < 4; ++ks) bfr[nj][ks] = *(const bf16x8*)(Bf + (size_t)(nj * 64 + ks) * 512);
    for (int kt = 0; kt < 16; ++kt) {
      lds_barrier();
#pragma unroll
      for (int q = 0; q < 2 * MI; ++q) *(u32x4*)(sA + (lrow + 32 * q) * 72 + lkc) = ra[q];
      lds_barrier();
      const int kn = kt < 15 ? kt + 1 : 15;
#pragma unroll
      for (int q = 0; q < 2 * MI; ++q) ra[q] = *(const u32x4*)(Ag + (size_t)q * 32 * 1024 + kn * 64);
      __builtin_amdgcn_sched_barrier(0);
      __builtin_amdgcn_s_setprio(2);
#pragma unroll
      for (int ks = 0; ks < 4; ++ks) {
        bf16x8 a[MI];
#pragma unroll
        for (int mi = 0; mi < MI; ++mi) a[mi] = *(const bf16x8*)(sA + (wr * (32 * MI) + mi * 32 + (lane & 31)) * 72 + ks * 16 + (lane >> 5) * 8);
#pragma unroll
        for (int mi = 0; mi < MI; ++mi)
#pragma unroll
          for (int nj = 0; nj < 2; ++nj) acc[mi][nj] = MFMA32(a[mi], bfr[nj][ks], acc[mi][nj]);
#pragma unroll
        for (int nj = 0; nj < 2; ++nj) bfr[nj][ks] = *(const bf16x8*)(Bf + (size_t)(nj * 64 + kn * 4 + ks) * 512);
      }
      __builtin_amdgcn_s_setprio(0);
    }
    epi(mt * BM + wr * (32 * MI), nt, wc, lane, acc, pre);
  }
}

DI unsigned pair_pk(float v0, float v1, int lane) {
  const bool odd = lane & 1;
  const float send = odd ? v0 : v1;
  const float recv = __builtin_bit_cast(float, __builtin_amdgcn_update_dpp(0, __builtin_bit_cast(int, send), 0xB1, 0xF, 0xF, true));
  return odd ? pk2(recv, v1) : pk2(v0, recv);
}
template <int MI> struct Epi1 {
  struct Pre {};
  DI void prefetch(int, int, int, int, Pre&) const {}
  bf16_t* CH; bf16_t* G1; float* out;
  template <bool TAIL> DI void body(int row0, int nt, int wc, int lane, const f32x16 (&acc)[MI][2]) const {
    const int ch = nt * 32 + (lane & 31);
    bf16_t* dst = (wc == 0 ? CH : G1) + (ch & ~1);
#pragma unroll
    for (int mi = 0; mi < MI; ++mi)
#pragma unroll
      for (int ip = 0; ip < 8; ++ip) {
        float v[2];
#pragma unroll
        for (int u = 0; u < 2; ++u) {
          const int i = 2 * ip + u;
          v[u] = wc == 0 ? acc[mi][0][i] * acc[mi][1][i] : acc[mi][0][i] * silu(acc[mi][1][i]);
          if (TAIL && wc == 0) {
            const int row = row0 + mi * 32 + rowi(i, lane);
            if (row < MP) { const int t = row & 2047; if (t >= 2046) out[OUT_CAP + (size_t)((row >> 11) * 2 + (t - 2046)) * 1024 + ch] = v[u]; }
            else { const int t = row & 7; if (t >= 6) out[OUT_CAS + (size_t)(((row - MP) >> 3) * 2 + (t - 6)) * 1024 + ch] = v[u]; }
          }
        }
        const int row = row0 + mi * 32 + rowi(2 * ip + (lane & 1), lane);
        *(unsigned*)(dst + (size_t)row * 1024) = pair_pk(v[0], v[1], lane);
      }
  }
  DI void operator()(int row0, int nt, int wc, int lane, const f32x16 (&acc)[MI][2], const Pre& pre) const {
    const bool tail = row0 >= MP || ((row0 + 32 * MI - 1) & 2047) >= 2046;
    if (tail) body<true>(row0, nt, wc, lane, acc); else body<false>(row0, nt, wc, lane, acc);
  }
};
template <int MI> struct Epi2 {
  Params p;
  struct Pre { float v[MI][2][16]; };
  DI void prefetch(int row0, int nt, int wc, int lane, Pre& pre) const {
    const float* base = xrow(p, row0 + 4 * (lane >> 5)) + nt * 128 + wc * 64 + (lane & 31);
#pragma unroll
    for (int mi = 0; mi < MI; ++mi)
#pragma unroll
      for (int i = 0; i < 16; ++i)
#pragma unroll
        for (int nj = 0; nj < 2; ++nj) pre.v[mi][nj][i] = base[(mi * 32 + (i & 3) + 8 * (i >> 2)) * 1024 + nj * 32];
  }
  template <bool PROMPT> DI void body(int row0, int nt, int wc, int lane, const f32x16 (&acc)[MI][2], const Pre& pre) const {
    const float* MOD = (const float*)(p.ws + WS_MOD);
    const int c0 = nt * 128 + wc * 64 + (lane & 31);
    float g0 = 0.f, g1 = 0.f;
    if (PROMPT) { const float* gt = MOD + (size_t)(row0 >> 11) * 3072 + 2048 + c0; g0 = gt[0]; g1 = gt[32]; }
#pragma unroll
    for (int mi = 0; mi < MI; ++mi)
#pragma unroll
      for (int i = 0; i < 16; ++i) {
        const int row = row0 + mi * 32 + rowi(i, lane);
        if (!PROMPT) { const float* gt = MOD + (size_t)bidx(row) * 3072 + 2048 + c0; g0 = gt[0]; g1 = gt[32]; }
        float* yp = p.out + OUT_Y + (size_t)row * 1024 + c0;
        yp[0] = ALPHA_F * pre.v[mi][0][i] + g0 * acc[mi][0][i];
        yp[32] = ALPHA_F * pre.v[mi][1][i] + g1 * acc[mi][1][i];
      }
  }
  DI void operator()(int row0, int nt, int wc, int lane, const f32x16 (&acc)[MI][2], const Pre& pre) const {
    if (row0 < MP) body<true>(row0, nt, wc, lane, acc, pre); else body<false>(row0, nt, wc, lane, acc, pre);
  }
};
template <int MI> struct Epi3 {
  Params p;
  struct Pre {};
  DI void prefetch(int, int, int, int, Pre&) const {}
  template <bool TAIL> DI void body(int row0, int nt, int wc, int lane, const f32x16 (&acc)[MI][2]) const {
    bf16_t* QKV = (bf16_t*)(p.ws + WS_QKV); bf16_t* Z = (bf16_t*)(p.ws + WS_Z); float* BA = (float*)(p.ws + WS_BA);
    if (nt < 32) {
#pragma unroll
      for (int nj = 0; nj < 2; ++nj) {
        const int col = nt * 128 + wc * 64 + nj * 32 + (lane & 31);
        bf16_t* dst = nt < 24 ? QKV + (col & ~1) : Z + ((col - 3072) & ~1);
        const int ld = nt < 24 ? 3072 : 1024;
#pragma unroll
        for (int mi = 0; mi < MI; ++mi)
#pragma unroll
          for (int ip = 0; ip < 8; ++ip) {
            if (TAIL && nt < 24) {
#pragma unroll
              for (int u = 0; u < 2; ++u) {
                const int row = row0 + mi * 32 + rowi(2 * ip + u, lane);
                const float v = acc[mi][nj][2 * ip + u];
                if (row < MP) { const int t = row & 2047; if (t >= 2045) p.out[OUT_CBP + (size_t)((row >> 11) * 3 + (t - 2045)) * 3072 + col] = v; }
                else { const int t = row & 7; if (t >= 5) p.out[OUT_CBS + (size_t)(((row - MP) >> 3) * 3 + (t - 5)) * 3072 + col] = v; }
              }
            }
            const int row = row0 + mi * 32 + rowi(2 * ip + (lane & 1), lane);
            *(unsigned*)(dst + (size_t)row * ld) = pair_pk(acc[mi][nj][2 * ip], acc[mi][nj][2 * ip + 1], lane);
          }
      }
    } else if (wc == 0 && (lane & 31) < 16) {
#pragma unroll
      for (int mi = 0; mi < MI; ++mi)
#pragma unroll
        for (int i = 0; i < 16; ++i) BA[(size_t)(row0 + mi * 32 + rowi(i, lane)) * 16 + (lane & 31)] = acc[mi][0][i];
    }
  }
  DI void operator()(int row0, int nt, int wc, int lane, const f32x16 (&acc)[MI][2], const Pre& pre) const {
    const bool tail = row0 >= MP || ((row0 + 32 * MI - 1) & 2047) >= 2045;
    if (tail) body<true>(row0, nt, wc, lane, acc); else body<false>(row0, nt, wc, lane, acc);
  }
};
template <int MI> struct Epi4 {
  Params p;
  struct Pre { float v[MI][2][16]; };
  DI void prefetch(int row0, int nt, int wc, int lane, Pre& pre) const {
    const float* base = p.out + OUT_Y + (size_t)(row0 + 4 * (lane >> 5)) * 1024 + nt * 128 + wc * 64 + (lane & 31);
#pragma unroll
    for (int mi = 0; mi < MI; ++mi)
#pragma unroll
      for (int i = 0; i < 16; ++i)
#pragma unroll
        for (int nj = 0; nj < 2; ++nj) pre.v[mi][nj][i] = base[(mi * 32 + (i & 3) + 8 * (i >> 2)) * 1024 + nj * 32];
  }
  template <bool PROMPT> DI void body(int row0, int nt, int wc, int lane, const f32x16 (&acc)[MI][2], const Pre& pre) const {
    const float* MOD = (const float*)(p.ws + WS_MOD) + (size_t)136 * 3072;
    const float* ST = (const float*)(p.ws + WS_STATS);
    const int c0 = nt * 128 + wc * 64 + (lane & 31);
    const float lg0 = p.ln_g[c0], lg1 = p.ln_g[c0 + 32], lb0 = p.ln_b[c0], lb1 = p.ln_b[c0 + 32];
    float g0 = 0.f, g1 = 0.f;
    if (PROMPT) { const float* gt = MOD + (size_t)(row0 >> 11) * 3072 + 2048 + c0; g0 = gt[0]; g1 = gt[32]; }
#pragma unroll
    for (int mi = 0; mi < MI; ++mi)
#pragma unroll
      for (int i = 0; i < 16; ++i) {
        const int row = row0 + mi * 32 + rowi(i, lane);
        const float mu = ST[row * 2], rstd = ST[row * 2 + 1];
        if (!PROMPT) { const float* gt = MOD + (size_t)bidx(row) * 3072 + 2048 + c0; g0 = gt[0]; g1 = gt[32]; }
        float* yp = p.out + OUT_Y + (size_t)row * 1024 + c0;
        yp[0] = ALPHA_F * ((pre.v[mi][0][i] - mu) * rstd * lg0 + lb0) + g0 * acc[mi][0][i];
        yp[32] = ALPHA_F * ((pre.v[mi][1][i] - mu) * rstd * lg1 + lb1) + g1 * acc[mi][1][i];
      }
  }
  DI void operator()(int row0, int nt, int wc, int lane, const f32x16 (&acc)[MI][2], const Pre& pre) const {
    if (row0 < MP) body<true>(row0, nt, wc, lane, acc, pre); else body<false>(row0, nt, wc, lane, acc, pre);
  }
};

DI void phase3(const Params& p) {
  const bf16_t* CH = (const bf16_t*)(p.ws + WS_CH); const bf16_t* G1 = (const bf16_t*)(p.ws + WS_G1);
  bf16_t* AB = (bf16_t*)(p.ws + WS_ABUF);
  for (int i = blockIdx.x * 256 + otid(); i < MTOT * 128; i += gridDim.x * 256) {
    const int row = i >> 7, c8 = (i & 127) * 8;
    const bool smp = row >= MP;
    const int t = smp ? (row & 7) : (row & 2047);
    float cur[8], p1[8], p2[8], g[8];
    { const u32x4 r = *(const u32x4*)(CH + (size_t)row * 1024 + c8);
#pragma unroll
      for (int e = 0; e < 4; ++e) { cur[2 * e] = bflo(r[e]); cur[2 * e + 1] = bfhi(r[e]); } }
    { const u32x4 r = *(const u32x4*)(G1 + (size_t)row * 1024 + c8);
#pragma unroll
      for (int e = 0; e < 4; ++e) { g[2 * e] = bflo(r[e]); g[2 * e + 1] = bfhi(r[e]); } }
    if (t >= 1) { const u32x4 r = *(const u32x4*)(CH + (size_t)(row - 1) * 1024 + c8);
#pragma unroll
      for (int e = 0; e < 4; ++e) { p1[2 * e] = bflo(r[e]); p1[2 * e + 1] = bfhi(r[e]); } }
    else if (smp) { const float* b = p.st_conv_a + ((size_t)((row - MP) >> 3) * 2 + 1) * 1024 + c8;
#pragma unroll
      for (int e = 0; e < 8; ++e) p1[e] = b[e]; }
    else {
#pragma unroll
      for (int e = 0; e < 8; ++e) p1[e] = 0.f; }
    if (t >= 2) { const u32x4 r = *(const u32x4*)(CH + (size_t)(row - 2) * 1024 + c8);
#pragma unroll
      for (int e = 0; e < 4; ++e) { p2[2 * e] = bflo(r[e]); p2[2 * e + 1] = bfhi(r[e]); } }
    else if (smp) { const float* b = p.st_conv_a + ((size_t)((row - MP) >> 3) * 2 + t) * 1024 + c8;
#pragma unroll
      for (int e = 0; e < 8; ++e) p2[e] = b[e]; }
    else {
#pragma unroll
      for (int e = 0; e < 8; ++e) p2[e] = 0.f; }
    float o[8];
#pragma unroll
    for (int e = 0; e < 8; ++e) o[e] = g[e] * (p.wa_conv[c8 + e] * p2[e] + p.wa_conv[1024 + c8 + e] * p1[e] + p.wa_conv[2048 + c8 + e] * cur[e]);
    u32x4 ov; ov[0] = pk2(o[0], o[1]); ov[1] = pk2(o[2], o[3]); ov[2] = pk2(o[4], o[5]); ov[3] = pk2(o[6], o[7]);
    *(u32x4*)(AB + (size_t)row * 1024 + c8) = ov;
  }
}

template <int FINAL>
DI void ln_phase(const Params& p) {
  const int tid0 = otid();
  const int lane = tid0 & 63;
  const int gw = blockIdx.x * 4 + (tid0 >> 6), nw = gridDim.x * 4;
  const float* MOD1 = (const float*)(p.ws + WS_MOD) + (size_t)136 * 3072;
  float* ST = (float*)(p.ws + WS_STATS);
  bf16_t* AB = (bf16_t*)(p.ws + WS_ABUF);
  const float* lg = p.ln_g + (FINAL ? 1024 : 0); const float* lb = p.ln_b + (FINAL ? 1024 : 0);
  for (int row = gw; row < MTOT; row += nw) {
    float* yr = p.out + OUT_Y + (size_t)row * 1024;
    f32x4 v[4];
    float s = 0.f;
#pragma unroll
    for (int j = 0; j < 4; ++j) { v[j] = *(const f32x4*)(yr + j * 256 + lane * 4); s += v[j][0] + v[j][1] + v[j][2] + v[j][3]; }
#pragma unroll
    for (int o = 32; o >= 1; o >>= 1) s += __shfl_xor(s, o);
    const float mu = s * (1.f / 1024.f);
    float q = 0.f;
#pragma unroll
    for (int j = 0; j < 4; ++j)
#pragma unroll
      for (int e = 0; e < 4; ++e) { const float d = v[j][e] - mu; q += d * d; }
#pragma unroll
    for (int o = 32; o >= 1; o >>= 1) q += __shfl_xor(q, o);
    const float rstd = rsqrtf(q * (1.f / 1024.f) + 1e-5f);
    if (!FINAL && lane == 0) { ST[row * 2] = mu; ST[row * 2 + 1] = rstd; }
    const float* md = MOD1 + (size_t)bidx(row) * 3072;
#pragma unroll
    for (int j = 0; j < 4; ++j) {
      const int col = j * 256 + lane * 4;
      const f32x4 g4 = *(const f32x4*)(lg + col), b4 = *(const f32x4*)(lb + col);
      f32x4 x1;
#pragma unroll
      for (int e = 0; e < 4; ++e) x1[e] = (v[j][e] - mu) * rstd * g4[e] + b4[e];
      if (FINAL) { *(f32x4*)(yr + col) = x1; }
      else {
        const f32x4 sh = *(const f32x4*)(md + col), sc = *(const f32x4*)(md + 1024 + col);
        u32x2 o; o[0] = pk2(x1[0] * (1.f + sc[0]) + sh[0], x1[1] * (1.f + sc[1]) + sh[1]); o[1] = pk2(x1[2] * (1.f + sc[2]) + sh[2], x1[3] * (1.f + sc[3]) + sh[3]);
        *(u32x2*)(AB + (size_t)row * 1024 + col) = o;
      }
    }
  }
}

DI void gdn_chunk_local(const Params& p, char* smem0) {
  for (int task = blockIdx.x; task < 2048; task += gridDim.x) {
  int tid = threadIdx.x; asm volatile("" : "+v"(tid));
  int off0 = 0; asm volatile("" : "+v"(off0));
  char* smem = (char*)__builtin_assume_aligned(smem0 + (off0 & ~15), 16);
  const int lane = tid & 63, wave = __builtin_amdgcn_readfirstlane(tid >> 6);
  bf16_t* sq = (bf16_t*)smem;
  bf16_t* sk = sq + 64 * 136;
  bf16_t* sv = sk + 64 * 136;
  float* sAm = (float*)(smem + 3 * 17408);
  float* sc = (float*)(smem + 4 * 17408);
  float *sG = sc, *sBeta = sc + 64, *sRq = sc + 128, *sRk = sc + 192, *sSsq = sc + 256, *sSsk = sc + 320, *sBk = sc + 384, *sEg = sc + 448, *sKt = sc + 512;
  const bf16_t* QKV = (const bf16_t*)(p.ws + WS_QKV);
  const float* BA = (const float*)(p.ws + WS_BA);
  float* GL = (float*)(p.ws + WS_GL);
  bf16_t* Ug = (bf16_t*)(p.ws + WS_U); bf16_t* Wg = (bf16_t*)(p.ws + WS_W); bf16_t* ATT = (bf16_t*)(p.ws + WS_ATTN);
  bf16_t* QG = (bf16_t*)(p.out + OUT_SSS); bf16_t* KT = QG + (size_t)2048 * 8192;
  {
    const int n = task & 31, h = (task >> 5) & 7, b = task >> 8;
    const int row0 = b * 2048 + n * 64;
    {
      const int cg16 = tid & 15, rsub = tid >> 4;
      u32x4 raw[3][7];
#pragma unroll
      for (int seg = 0; seg < 3; ++seg)
#pragma unroll
        for (int r7 = 0; r7 < 7; ++r7) {
          const int ii = rsub * 4 - 3 + r7;
          if (n * 64 + ii >= 0) raw[seg][r7] = *(const u32x4*)(QKV + (size_t)(row0 + ii) * 3072 + seg * 1024 + h * 128 + cg16 * 8);
          else { raw[seg][r7][0] = 0u; raw[seg][r7][1] = 0u; raw[seg][r7][2] = 0u; raw[seg][r7][3] = 0u; }
        }
#pragma unroll
      for (int seg = 0; seg < 3; ++seg) {
        const int colbase = seg * 1024 + h * 128 + cg16 * 8;
        float wt[4][8];
#pragma unroll
        for (int j = 0; j < 4; ++j) {
          const f32x4 w0 = *(const f32x4*)(p.wb_conv + j * 3072 + colbase), w1 = *(const f32x4*)(p.wb_conv + j * 3072 + colbase + 4);
#pragma unroll
          for (int e = 0; e < 4; ++e) { wt[j][e] = w0[e]; wt[j][4 + e] = w1[e]; }
        }
        bf16_t* dst = sq + seg * (64 * 136);
#pragma unroll
        for (int o4 = 0; o4 < 4; ++o4) {
          const int i = rsub * 4 + o4;
          float a8[8];
#pragma unroll
          for (int e = 0; e < 8; ++e) a8[e] = 0.f;
#pragma unroll
          for (int j = 0; j < 4; ++j) {
#pragma unroll
            for (int e = 0; e < 4; ++e) { a8[2 * e] += wt[j][2 * e] * bflo(raw[seg][o4 + j][e]); a8[2 * e + 1] += wt[j][2 * e + 1] * bfhi(raw[seg][o4 + j][e]); }
          }
          float ss = 0.f;
#pragma unroll
          for (int e = 0; e < 8; ++e) { a8[e] = silu(a8[e]); ss += a8[e] * a8[e]; }
          u32x4 o; o[0] = pk2(a8[0], a8[1]); o[1] = pk2(a8[2], a8[3]); o[2] = pk2(a8[4], a8[5]); o[3] = pk2(a8[6], a8[7]);
          *(u32x4*)(dst + i * 136 + cg16 * 8) = o;
          if (seg < 2) {
#pragma unroll
            for (int o2 = 8; o2 >= 1; o2 >>= 1) ss += __shfl_xor(ss, o2);
            if (cg16 == 0) sSsq[seg * 64 + i] = ss;
          }
        }
      }
    }
    __syncthreads();
    if (tid < 64) {
      const int row = row0 + tid;
      const float bb = BA[(size_t)row * 16 + h], aa = BA[(size_t)row * 16 + 8 + h];
      const float beta = 1.f / (1.f + expf(-bb));
      const float xx = aa + p.wb_dt_bias[h];
      const float sp = xx > 20.f ? xx : log1pf(expf(xx));
      const float g = -expf(p.wb_a_log[h]) * sp;
      float G = g;
#pragma unroll
      for (int off = 1; off < 64; off <<= 1) { const float tv = __shfl_up(G, off); if (lane >= off) G += tv; }
      const float Gl = __shfl(G, 63);
      const float rk = rsqrtf(sSsk[tid] + 1e-6f), rq = rsqrtf(sSsq[tid] + 1e-6f) * 0.08838834764831845f;
      const float eg = expf(G);
      sG[tid] = G; sBeta[tid] = beta; sRq[tid] = rq * eg; sRk[tid] = rk; sBk[tid] = rk * beta * eg; sEg[tid] = rq; sKt[tid] = rk * expf(Gl - G);
      if (tid == 63) GL[task] = eg;
    }
    __syncthreads();
    {
      bf16_t* qgo = QG + (size_t)task * 8192; bf16_t* kto = KT + (size_t)task * 8192;
#pragma unroll
      for (int c4 = 0; c4 < 4; ++c4) {
        const int o = tid + 256 * c4;
        {
          const int mt = o >> 9, s = (o >> 6) & 7, ln = o & 63, i = mt * 32 + (ln & 31), hh = ln >> 5;
          const u32x2 lo = *(const u32x2*)(sq + i * 136 + s * 16 + hh * 4), hi = *(const u32x2*)(sq + i * 136 + s * 16 + 8 + hh * 4);
          const float f = sRq[i];
          u32x4 ov; ov[0] = pk2(bflo(lo[0]) * f, bfhi(lo[0]) * f); ov[1] = pk2(bflo(lo[1]) * f, bfhi(lo[1]) * f);
          ov[2] = pk2(bflo(hi[0]) * f, bfhi(hi[0]) * f); ov[3] = pk2(bflo(hi[1]) * f, bfhi(hi[1]) * f);
          *(u32x4*)(qgo + (size_t)o * 8) = ov;
        }
        {
          const int mt = o >> 8, s = (o >> 6) & 3, ln = o & 63, m = mt * 32 + (ln & 31), hh = ln >> 5;
          float vv[8];
#pragma unroll
          for (int e = 0; e < 8; ++e) { const int j = s * 16 + (e >> 2) * 8 + hh * 4 + (e & 3); vv[e] = bf2f(sk[j * 136 + m]) * sKt[j]; }
          u32x4 ov; ov[0] = pk2(vv[0], vv[1]); ov[1] = pk2(vv[2], vv[3]); ov[2] = pk2(vv[4], vv[5]); ov[3] = pk2(vv[6], vv[7]);
          *(u32x4*)(kto + (size_t)o * 8) = ov;
        }
      }
    }
    const int mat = wave >> 1, gmi = wave & 1;
    f32x16 g2[2];
#pragma unroll
    for (int nj = 0; nj < 2; ++nj)
#pragma unroll
      for (int i = 0; i < 16; ++i) g2[nj][i] = 0.f;
    {
      const bf16_t* srcA = mat ? sq : sk;
#pragma unroll
      for (int ks = 0; ks < 8; ++ks) {
        const bf16x8 a = *(const bf16x8*)(srcA + (gmi * 32 + (lane & 31)) * 136 + ks * 16 + (lane >> 5) * 8);
#pragma unroll
        for (int nj = 0; nj < 2; ++nj) {
          const bf16x8 bb = *(const bf16x8*)(sk + (nj * 32 + (lane & 31)) * 136 + ks * 16 + (lane >> 5) * 8);
          g2[nj] = MFMA32(a, bb, g2[nj]);
        }
      }
    }
    __syncthreads();
#pragma unroll
    for (int nj = 0; nj < 2; ++nj)
#pragma unroll
      for (int r = 0; r < 16; ++r) {
        const int i = gmi * 32 + rowi(r, lane), j = nj * 32 + (lane & 31);
        const float dec = __expf(fminf(sG[i] - sG[j], 0.f));
        if (mat == 0) {
          sAm[i * 68 + j] = (i > j) ? sBeta[i] * sRk[i] * sRk[j] * dec * g2[nj][r] : 0.f;
        } else {
          const float val = (i >= j) ? sEg[i] * sRk[j] * dec * g2[nj][r] : 0.f;
          const int s = j >> 4, q = j & 15, e = (q >> 3) * 4 + (q & 3), hh = (q >> 2) & 1, ln = (i & 31) + 32 * hh;
          sq[((gmi * 4 + s) * 64 + ln) * 8 + e] = (bf16_t)f2bf(val);
        }
      }
    __syncthreads();
#pragma unroll
    for (int c = 0; c < 2; ++c) { const int o = tid + 256 * c; *(u32x4*)(ATT + (size_t)task * 4096 + (size_t)o * 8) = *(const u32x4*)(sq + o * 8); }
    typedef float f32x2 __attribute__((ext_vector_type(2)));
    f32x2 xv[32];
    {
      const bool isV = tid < 128;
      const bf16_t* src = isV ? (sv + tid) : (sk + (tid - 128));
      const float* scl = isV ? sBeta : sBk;
#pragma unroll
      for (int i = 0; i < 64; ++i) {
        f32x2 r0 = {bf2f(src[i * 136]) * scl[i], 0.f}, r1 = {0.f, 0.f};
#pragma unroll
        for (int m = 0; m < i / 2; ++m) {
          const f32x2 a2 = *(const f32x2*)(sAm + i * 68 + 2 * m);
          if (m & 1) r1 -= a2 * xv[m]; else r0 -= a2 * xv[m];
        }
        r0 += r1;
        float r = r0[0] + r0[1];
        if (i & 1) r -= sAm[i * 68 + i - 1] * xv[i / 2][0];
        xv[i / 2][i & 1] = r;
      }
    }
#define XS(i) xv[(i) >> 1][(i) & 1]
    __syncthreads();
    if (tid < 128) {
      const int s = tid >> 5, nn = tid & 31;
#pragma unroll
      for (int i = 0; i < 64; ++i) {
        const int mt = i >> 5, ii = i & 31, hh = (ii >> 2) & 1, r = (ii >> 3) * 4 + (ii & 3);
        sv[((s * 2 + mt) * 64 + nn + 32 * hh) * 16 + r] = (bf16_t)f2bf(XS(i));
      }
    } else {
      const int c = tid - 128, s = c >> 4, q = c & 15, e = (q >> 3) * 4 + (q & 3), hh = (q >> 2) & 1;
#pragma unroll
      for (int i = 0; i < 64; ++i) {
        const int mt = i >> 5;
        sk[((mt * 8 + s) * 64 + (i & 31) + 32 * hh) * 8 + e] = (bf16_t)f2bf(XS(i));
      }
    }
    __syncthreads();
#pragma unroll
    for (int c = 0; c < 4; ++c) {
      const int o = tid + 256 * c;
      *(u32x4*)(Ug + (size_t)task * 8192 + (size_t)o * 8) = *(const u32x4*)(sv + o * 8);
      *(u32x4*)(Wg + (size_t)task * 8192 + (size_t)o * 8) = *(const u32x4*)(sk + o * 8);
    }
    __syncthreads();
  }
  }
}

DI void gdn_scan(const Params& p, char* smem) {
  if (blockIdx.x >= 256) return;
  const int tid = otid(), lane = tid & 63, wave = __builtin_amdgcn_readfirstlane(tid >> 6);
  const int xcd = blockIdx.x & 7, yy = blockIdx.x >> 3;
  const int bh = xcd * 8 + (yy >> 2), s = yy & 3, h = bh & 7, b = bh >> 3;
  bf16x8* Sfrag = (bf16x8*)smem;
  bf16x8* Vfrag = Sfrag + 512;
  const bf16_t* Ug = (const bf16_t*)(p.ws + WS_U); const bf16_t* Wg = (const bf16_t*)(p.ws + WS_W); const bf16_t* ATT = (const bf16_t*)(p.ws + WS_ATTN);
  const bf16_t* QG = (const bf16_t*)(p.out + OUT_SSS); const bf16_t* KT = QG + (size_t)2048 * 8192;
  const float* GL = (const float*)(p.ws + WS_GL);
  bf16_t* O = (bf16_t*)(p.ws + WS_O);
  const size_t cbase = (size_t)(b * 8 + h) * 32;
  const bool isW = wave < 2; const int mi = wave & 1;
  f32x16 S;
#pragma unroll
  for (int i = 0; i < 16; ++i) S[i] = 0.f;
  { bf16x8 z; for (int e = 0; e < 8; ++e) z[e] = 0; for (int o = tid; o < 512; o += 256) Sfrag[o] = z; }
  const bf16_t* aBase = (isW ? Wg : QG) + cbase * 8192 + (size_t)(mi * 8) * 512 + lane * 8;
  const bf16_t* kBase = KT + cbase * 8192 + (size_t)(wave * 4) * 512 + lane * 8;
  const bf16_t* tBase = ATT + cbase * 4096 + (size_t)(mi * 4) * 512 + lane * 8;
  const bf16_t* uBase = Ug + cbase * 8192 + (size_t)((s * 2 + mi) * 64 + lane) * 16;
  struct Regs { bf16x8 afr[8], kfr[4], tfr[4]; u32x4 ur[2]; };
  const float glv = GL[cbase + (lane & 31)];
  Regs R0, R1;
  auto load_all = [&](Regs& R, int n) {
#pragma unroll
    for (int ks = 0; ks < 8; ++ks) R.afr[ks] = *(const bf16x8*)(aBase + (size_t)n * 8192 + ks * 512);
#pragma unroll
    for (int k4 = 0; k4 < 4; ++k4) { R.kfr[k4] = *(const bf16x8*)(kBase + (size_t)n * 8192 + k4 * 512); R.tfr[k4] = *(const bf16x8*)(tBase + (size_t)n * 4096 + k4 * 512); }
    R.ur[0] = *(const u32x4*)(uBase + (size_t)n * 8192); R.ur[1] = *(const u32x4*)(uBase + (size_t)n * 8192 + 8);
  };
  load_all(R0, 0);
  load_all(R1, 1);
  __syncthreads();
  auto step = [&](Regs& R, const int n) {
    const int nn = n + 2 < 32 ? n + 2 : 31;
    f32x16 acc0, acc1;
#pragma unroll
    for (int i = 0; i < 16; ++i) { acc0[i] = 0.f; acc1[i] = 0.f; }
#pragma unroll
    for (int ks = 0; ks < 8; ks += 2) {
      acc0 = MFMA32(R.afr[ks], Sfrag[ks * 64 + lane], acc0);
      acc1 = MFMA32(R.afr[ks + 1], Sfrag[(ks + 1) * 64 + lane], acc1);
    }
#pragma unroll
    for (int i = 0; i < 16; ++i) acc0[i] += acc1[i];
#pragma unroll
    for (int ks = 0; ks < 8; ++ks) R.afr[ks] = *(const bf16x8*)(aBase + (size_t)nn * 8192 + ks * 512);
    if (isW) {
      f32x16 vn;
#pragma unroll
      for (int e = 0; e < 4; ++e) {
        vn[2 * e] = bflo(R.ur[0][e]) - acc0[2 * e]; vn[2 * e + 1] = bfhi(R.ur[0][e]) - acc0[2 * e + 1];
        vn[8 + 2 * e] = bflo(R.ur[1][e]) - acc0[8 + 2 * e]; vn[8 + 2 * e + 1] = bfhi(R.ur[1][e]) - acc0[8 + 2 * e + 1];
      }
      Vfrag[(2 * mi) * 64 + lane] = pack8(vn, 0);
      Vfrag[(2 * mi + 1) * 64 + lane] = pack8(vn, 1);
      R.ur[0] = *(const u32x4*)(uBase + (size_t)nn * 8192); R.ur[1] = *(const u32x4*)(uBase + (size_t)nn * 8192 + 8);
    }
    lds_barrier();
    if (!isW) {
#pragma unroll
      for (int k4 = 0; k4 < 4; ++k4) acc0 = MFMA32(R.tfr[k4], Vfrag[k4 * 64 + lane], acc0);
      bf16_t* op = O + (size_t)(b * 2048 + n * 64 + mi * 32) * 1024 + h * 128 + s * 32 + (lane & 30);
#pragma unroll
      for (int ip = 0; ip < 8; ++ip) *(unsigned*)(op + (size_t)rowi(2 * ip + (lane & 1), lane) * 1024) = pair_pk(acc0[2 * ip], acc0[2 * ip + 1], lane);
#pragma unroll
      for (int k4 = 0; k4 < 4; ++k4) R.tfr[k4] = *(const bf16x8*)(tBase + (size_t)nn * 4096 + k4 * 512);
    }
    const float gl = __builtin_bit_cast(float, __builtin_amdgcn_readlane(__builtin_bit_cast(int, glv), n));
#pragma unroll
    for (int i = 0; i < 16; ++i) S[i] *= gl;
#pragma unroll
    for (int k4 = 0; k4 < 4; ++k4) S = MFMA32(R.kfr[k4], Vfrag[k4 * 64 + lane], S);
#pragma unroll
    for (int k4 = 0; k4 < 4; ++k4) R.kfr[k4] = *(const bf16x8*)(kBase + (size_t)nn * 8192 + k4 * 512);
    Sfrag[(2 * wave) * 64 + lane] = pack8(S, 0);
    Sfrag[(2 * wave + 1) * 64 + lane] = pack8(S, 1);
    lds_barrier();
  };
#pragma unroll 1
  for (int n = 0; n < 32; n += 2) { step(R0, n); step(R1, n + 1); }
  float* so = p.out + OUT_SSP + ((size_t)(b * 8 + h) * 128 + wave * 32) * 128 + s * 32 + (lane & 31);
#pragma unroll
  for (int r = 0; r < 16; ++r) so[(size_t)rowi(r, lane) * 128] = S[r];
}

DI void sample_task(const Params& p, char* smem, int task) {
  const int tid = otid(), lane = tid & 63, wave = tid >> 6;
  const int bs = task >> 3, h = task & 7;
  float* fq = (float*)smem; float* fk = fq + 1024; float* fv = fk + 1024; float* red = fv + 1024; float* ored = red + 2048; float* scal = ored + 2048;
  const bf16_t* QKV = (const bf16_t*)(p.ws + WS_QKV); const float* BA = (const float*)(p.ws + WS_BA);
  const bf16_t* Z = (const bf16_t*)(p.ws + WS_Z); bf16_t* AB = (bf16_t*)(p.ws + WS_ABUF);
  const int rowb = MP + bs * 8;
#pragma unroll
  for (int it = 0; it < 12; ++it) {
    const int idx = tid + 256 * it;
    const int tok = idx / 384, cc = idx - tok * 384, seg = cc >> 7, c = cc & 127, col = seg * 1024 + h * 128 + c;
    float acc = 0.f;
#pragma unroll
    for (int j = 0; j < 4; ++j) {
      const int tt = tok + j;
      const float xs = p.st_conv_b[((size_t)bs * 3 + (tt < 3 ? tt : 2)) * 3072 + col];
      const float xq = bf2f(QKV[(size_t)(rowb + (tt >= 3 ? tt - 3 : 0)) * 3072 + col]);
      acc += p.wb_conv[j * 3072 + col] * (tt < 3 ? xs : xq);
    }
    (seg == 0 ? fq : (seg == 1 ? fk : fv))[tok * 128 + c] = silu(acc);
  }
  if (tid < 8) {
    const int row = rowb + tid;
    const float bb = BA[(size_t)row * 16 + h], aa = BA[(size_t)row * 16 + 8 + h];
    const float xx = aa + p.wb_dt_bias[h];
    const float sp = xx > 20.f ? xx : log1pf(expf(xx));
    scal[tid] = 1.f / (1.f + expf(-bb));
    scal[8 + tid] = expf(-expf(p.wb_a_log[h]) * sp);
  }
  __syncthreads();
#pragma unroll
  for (int rr = 0; rr < 4; ++rr) {
    const int r16 = wave * 4 + rr;
    float* ptr = r16 < 8 ? fq + r16 * 128 : fk + (r16 - 8) * 128;
    const float a0 = ptr[lane], a1 = ptr[lane + 64];
    float ss = a0 * a0 + a1 * a1;
#pragma unroll
    for (int o = 32; o >= 1; o >>= 1) ss += __shfl_xor(ss, o);
    const float f = rsqrtf(ss + 1e-6f) * (r16 < 8 ? 0.08838834764831845f : 1.f);
    ptr[lane] = a0 * f; ptr[lane + 64] = a1 * f;
  }
  __syncthreads();
  const int vcol = tid & 127, kh = tid >> 7;
  float S[64];
  {
    const float* sp = p.st_ssm + (((size_t)bs * 8 + h) * 128 + kh * 64) * 128 + vcol;
#pragma unroll
    for (int kk = 0; kk < 64; ++kk) S[kk] = sp[(size_t)kk * 128];
  }
#pragma unroll 1
  for (int t = 0; t < 8; ++t) {
    const float* kt = fk + t * 128 + kh * 64;
    const float* qt = fq + t * 128 + kh * 64;
    float part = 0.f;
#pragma unroll
    for (int kk = 0; kk < 64; ++kk) part += kt[kk] * S[kk];
    red[(t * 2 + kh) * 128 + vcol] = part;
    __syncthreads();
    const float kS = red[(t * 2) * 128 + vcol] + red[(t * 2 + 1) * 128 + vcol];
    const float a = scal[8 + t], be = scal[t];
    const float d = be * (fv[t * 128 + vcol] - a * kS);
    float op = 0.f;
#pragma unroll
    for (int kk = 0; kk < 64; ++kk) { S[kk] = a * S[kk] + kt[kk] * d; op += qt[kk] * S[kk]; }
    ored[(t * 2 + kh) * 128 + vcol] = op;
  }
  {
    float* so = p.out + OUT_SSS + (((size_t)bs * 8 + h) * 128 + kh * 64) * 128 + vcol;
#pragma unroll
    for (int kk = 0; kk < 64; ++kk) so[(size_t)kk * 128] = S[kk];
  }
  __syncthreads();
  {
    const int tok = tid >> 5, c4 = (tid & 31) * 4;
    float o[4]; float ss = 0.f;
#pragma unroll
    for (int e = 0; e < 4; ++e) { o[e] = ored[(tok * 2) * 128 + c4 + e] + ored[(tok * 2 + 1) * 128 + c4 + e]; ss += o[e] * o[e]; }
#pragma unroll
    for (int o2 = 16; o2 >= 1; o2 >>= 1) ss += __shfl_xor(ss, o2);
    const float rstd = rsqrtf(ss * (1.f / 128.f) + 1e-6f);
    const u32x2 zr = *(const u32x2*)(Z + (size_t)(rowb + tok) * 1024 + h * 128 + c4);
    const float z0 = bflo(zr[0]), z1 = bfhi(zr[0]), z2 = bflo(zr[1]), z3 = bfhi(zr[1]);
    u32x2 ov;
    ov[0] = pk2(o[0] * rstd * p.wb_norm[c4] * silu(z0), o[1] * rstd * p.wb_norm[c4 + 1] * silu(z1));
    ov[1] = pk2(o[2] * rstd * p.wb_norm[c4 + 2] * silu(z2), o[3] * rstd * p.wb_norm[c4 + 3] * silu(z3));
    *(u32x2*)(AB + (size_t)(rowb + tok) * 1024 + h * 128 + c4) = ov;
  }
  __syncthreads();
}

DI void phase9(const Params& p, char* smem) {
  const int tid9 = otid();
  const int lane = tid9 & 63, wave = tid9 >> 6;
  const bf16_t* O = (const bf16_t*)(p.ws + WS_O); const bf16_t* Z = (const bf16_t*)(p.ws + WS_Z); bf16_t* AB = (bf16_t*)(p.ws + WS_ABUF);
  for (int task = blockIdx.x; task < 2048; task += gridDim.x) {
    if (task < 1024) { sample_task(p, smem, task); continue; }
    const int r0 = (task - 1024) * 16 + wave * 4;
#pragma unroll
    for (int rr = 0; rr < 4; ++rr) {
      const int row = r0 + rr;
#pragma unroll
      for (int j = 0; j < 4; ++j) {
        const int col = j * 256 + lane * 4;
        const u32x2 orw = *(const u32x2*)(O + (size_t)row * 1024 + col);
        f32x4 o4; o4[0] = bflo(orw[0]); o4[1] = bfhi(orw[0]); o4[2] = bflo(orw[1]); o4[3] = bfhi(orw[1]);
        float ss = o4[0] * o4[0] + o4[1] * o4[1] + o4[2] * o4[2] + o4[3] * o4[3];
#pragma unroll
        for (int o2 = 16; o2 >= 1; o2 >>= 1) ss += __shfl_xor(ss, o2);
        const float rstd = rsqrtf(ss * (1.f / 128.f) + 1e-6f);
        const u32x2 zr = *(const u32x2*)(Z + (size_t)row * 1024 + col);
        const f32x4 nw = *(const f32x4*)(p.wb_norm + (col & 127));
        u32x2 ov;
        ov[0] = pk2(o4[0] * rstd * nw[0] * silu(bflo(zr[0])), o4[1] * rstd * nw[1] * silu(bfhi(zr[0])));
        ov[1] = pk2(o4[2] * rstd * nw[2] * silu(bflo(zr[1])), o4[3] * rstd * nw[3] * silu(bfhi(zr[1])));
        *(u32x2*)(AB + (size_t)row * 1024 + col) = ov;
      }
    }
  }
}

__global__ void __launch_bounds__(256, 2) fwd_megakernel(Params p) {
  extern __shared__ __attribute__((aligned(16))) char smem[];
  cg::grid_group grid = cg::this_grid();
  if (p.out == nullptr) grid.sync();
  __shared__ uint4 xb_words;
  if (threadIdx.x == 0) xb_words = make_uint4(0u, 0u, 0u, 0u);
  __syncthreads();
  XcdBarrier xb = xcd_barrier_post((unsigned*)(p.ws + WS_BAR), (volatile LAS unsigned*)&xb_words);
#define GSYNC() xcd_barrier(xb)
  phase0a(p);
  GSYNC();
  phase0(p, smem);
  GSYNC();
  phase1(p);
  GSYNC();
  { Epi1<4> e{(bf16_t*)(p.ws + WS_CH), (bf16_t*)(p.ws + WS_G1), p.out}; gemm_phase<4>((const bf16_t*)(p.ws + WS_ABUF), (const bf16_t*)(p.ws + WS_WT1), 32, smem, e); }
  GSYNC();
  phase3(p);
  GSYNC();
  { Epi2<2> e{p}; gemm_phase<2>((const bf16_t*)(p.ws + WS_ABUF), (const bf16_t*)(p.ws + WS_WT2), 8, smem, e); }
  GSYNC();
  ln_phase<0>(p);
  GSYNC();
  { Epi3<4> e{p}; gemm_phase<4>((const bf16_t*)(p.ws + WS_ABUF), (const bf16_t*)(p.ws + WS_WT3), 33, smem, e); }
  GSYNC();
  gdn_chunk_local(p, smem);
  GSYNC();
  gdn_scan(p, smem);
  GSYNC();
  phase9(p, smem);
  GSYNC();
  { Epi4<2> e{p}; gemm_phase<2>((const bf16_t*)(p.ws + WS_ABUF), (const bf16_t*)(p.ws + WS_WT4), 8, smem, e); }
  GSYNC();
  ln_phase<1>(p);
}

extern "C" void kernel_launch(void* const* d_in, const int* in_sizes, int n_in, void* d_out, int out_size, void* d_ws, size_t ws_size, hipStream_t stream) {
  static int grid_blocks = 0;
  if (!grid_blocks) {
    int dev = 0, cus = 0, per_cu = 0;
    hipGetDevice(&dev);
    hipDeviceGetAttribute(&cus, hipDeviceAttributeMultiprocessorCount, dev);
    hipFuncSetAttribute((const void*)fwd_megakernel, hipFuncAttributeMaxDynamicSharedMemorySize, LDS_BYTES);
    hipOccupancyMaxActiveBlocksPerMultiprocessor(&per_cu, (const void*)fwd_megakernel, 256, LDS_BYTES);
    if (per_cu < 1) per_cu = 1;
    if (per_cu > 2) per_cu = 2;
    grid_blocks = cus * per_cu;
    if (ws_size < 247 * MiB) fprintf(stderr, "kernel_launch: workspace too small: %zu\n", ws_size);
  }
  Params p{};
  const float** pp = (const float**)&p;
  for (int i = 0; i < 20; ++i) pp[i] = (const float*)d_in[i];
  p.out = (float*)d_out; p.ws = (char*)d_ws;
  hipMemsetAsync((char*)d_ws + WS_BAR, 0, XCD_BAR_WORDS * 4, stream);
  void* args[] = {&p};
  hipError_t e = hipLaunchCooperativeKernel((const void*)fwd_megakernel, dim3(grid_blocks), dim3(256), args, LDS_BYTES, stream);
  if (e != hipSuccess) fprintf(stderr, "cooperative launch failed: %s (grid %d)\n", hipGetErrorString(e), grid_blocks);
}
```

```cpp
#include <hip/hip_runtime.h>
#include <hip/hip_cooperative_groups.h>
#include <cstdio>
namespace cg = cooperative_groups;

typedef unsigned short bf16_t;
typedef short bf16x8 __attribute__((ext_vector_type(8)));
typedef float f32x16 __attribute__((ext_vector_type(16)));
typedef float f32x4 __attribute__((ext_vector_type(4)));
typedef unsigned u32x4 __attribute__((ext_vector_type(4)));
typedef unsigned u32x2 __attribute__((ext_vector_type(2)));

#define DI __device__ __forceinline__
#define MFMA32(a, b, c) __builtin_amdgcn_mfma_f32_32x32x16_bf16((a), (b), (c), 0, 0, 0)

constexpr int MTOT = 17408, MP = 16384;
constexpr size_t MiB = 1ull << 20;
constexpr size_t WS_WT1 = 0, WS_WT2 = 8 * MiB, WS_WT3 = 10 * MiB, WS_WT4 = 19 * MiB, WS_MOD = 21 * MiB, WS_STATS = 25 * MiB,
                 WS_BA = 25 * MiB + 512 * 1024, WS_GL = 26 * MiB + 768 * 1024, WS_BAR = 26 * MiB + 832 * 1024, WS_CST = 24 * MiB + 256 * 1024, WS_ABUF = 27 * MiB, WS_CH = 61 * MiB, WS_G1 = 95 * MiB,
                 WS_QKV = 129 * MiB, WS_ATTN = 231 * MiB;
constexpr size_t WS_U = WS_ABUF, WS_Z = WS_CH, WS_W = WS_G1, WS_O = WS_QKV;
constexpr size_t OUT_Y = 0, OUT_CAP = 17825792, OUT_CBP = 17842176, OUT_SSP = 17915904, OUT_CAS = 18964480, OUT_CBS = 19226624, OUT_SSS = 20406272;
constexpr int LDS_BYTES = 72192;
constexpr float ALPHA_F = 1.41421356237309515f;

struct Params {
  const float *x_p, *x_s, *st_conv_a, *st_conv_b, *st_ssm, *c_p, *c_s, *w_mod, *b_mod, *ln_g, *ln_b, *wa_in, *wa_conv, *wa_out, *wb_in, *wb_conv,
      *wb_a_log, *wb_dt_bias, *wb_norm, *wb_out;
  float* out;
  char* ws;
};

typedef float f32x2v __attribute__((ext_vector_type(2)));
typedef __bf16 bf16x2v __attribute__((ext_vector_type(2)));
DI unsigned pk2(float lo, float hi) { f32x2v v = {lo, hi}; bf16x2v b = __builtin_convertvector(v, bf16x2v); return __builtin_bit_cast(unsigned, b); }
DI unsigned f2bf(float x) { __bf16 b = (__bf16)x; return (unsigned)__builtin_bit_cast(unsigned short, b); }
DI float bflo(unsigned u) { return __uint_as_float(u << 16); }
DI float bfhi(unsigned u) { return __uint_as_float(u & 0xffff0000u); }
DI float bf2f(bf16_t v) { return __uint_as_float(((unsigned)v) << 16); }
DI float silu(float x) { return x * __builtin_amdgcn_rcpf(1.f + __expf(-x)); }
DI int otid() { int t = threadIdx.x; asm volatile("" : "+v"(t)); return t; }
DI int rowi(int i, int lane) { return (i & 3) + 8 * (i >> 2) + 4 * (lane >> 5); }
DI int bidx(int row) { return row < MP ? (row >> 11) : 8 + ((row - MP) >> 3); }
DI const float* xrow(const Params& p, int row) { return row < MP ? p.x_p + (size_t)row * 1024 : p.x_s + (size_t)(row - MP) * 1024; }
DI bf16x8 pack8(const f32x16& x, int s) {
  u32x4 r;
  r[0] = pk2(x[8 * s + 0], x[8 * s + 1]); r[1] = pk2(x[8 * s + 2], x[8 * s + 3]); r[2] = pk2(x[8 * s + 4], x[8 * s + 5]); r[3] = pk2(x[8 * s + 6], x[8 * s + 7]);
  return __builtin_bit_cast(bf16x8, r);
}


#define XB_TMO      128
#define XB_XCNT(j)  (256  + 64 * (j))
#define XB_XSUB(j)  (1280 + 64 * (j))
#define XB_XGEN(j)  (2304 + 64 * (j))
#define XB_TOP      3328
#define XB_TOPGEN   3392
#define XCD_BAR_WORDS 3456
#define XB_SPIN_CAP (1u << 18)
#define LAS __attribute__((address_space(3)))
DI unsigned xb_ld(unsigned* p) { return __hip_atomic_load(p, __ATOMIC_RELAXED, __HIP_MEMORY_SCOPE_AGENT); }
DI unsigned xb_add(unsigned* p, unsigned v) { return __hip_atomic_fetch_add(p, v, __ATOMIC_RELAXED, __HIP_MEMORY_SCOPE_AGENT); }
DI unsigned xb_xcc_id() { return (unsigned)__builtin_amdgcn_s_getreg((3 << 11) | 20) & 0xFu; }
#define XB_SPIN(cond, bar) do { unsigned _sp = 0; while (cond) { __builtin_amdgcn_s_sleep(1); \
    if ((++_sp & 255u) == 0u) { if (xb_ld(&(bar)[XB_TMO])) break; if (_sp > XB_SPIN_CAP) { atomicAdd(&(bar)[XB_TMO], 1u); break; } } } } while (0)
struct XcdBarrier { unsigned* bar; unsigned x; volatile LAS unsigned* st; };
DI XcdBarrier xcd_barrier_post(unsigned* bar, volatile LAS unsigned* st) {
  XcdBarrier b; b.bar = bar; b.x = xb_xcc_id(); b.st = st;
  if (threadIdx.x == 0) (void)xb_add(&bar[XB_XCNT(b.x)], 1u);
  return b;
}
DI void xcd_barrier_complete(unsigned* bar, unsigned x, unsigned& nloc, unsigned& nx) {
  const unsigned G = gridDim.x * gridDim.y * gridDim.z;
  unsigned sum, cnt, mine, sp = 0u;
  for (;;) {
    sum = 0u; cnt = 0u; mine = 0u;
#pragma unroll
    for (unsigned j = 0; j < 16; ++j) { const unsigned c = xb_ld(&bar[XB_XCNT(j)]); sum += c; cnt += (c > 0u) ? 1u : 0u; mine = (j == x) ? c : mine; }
    if (sum == G) break;
    __builtin_amdgcn_s_sleep(1);
    if ((++sp & 255u) == 0u) { if (xb_ld(&bar[XB_TMO])) break; if (sp > XB_SPIN_CAP) { atomicAdd(&bar[XB_TMO], 1u); break; } }
  }
  nloc = mine > 0u ? mine : 1u; nx = cnt > 0u ? cnt : 1u;
}
DI void xcd_barrier(const XcdBarrier& b) {
  asm volatile("s_waitcnt vmcnt(0)" ::: "memory");
  __syncthreads();
  if (threadIdx.x == 0) {
    unsigned* bar = b.bar;
    __builtin_amdgcn_s_waitcnt(0);
    unsigned nloc = b.st[0], nx = b.st[1];
    if (nloc == 0u) { xcd_barrier_complete(bar, b.x, nloc, nx); b.st[0] = nloc; b.st[1] = nx; }
    const unsigned old = xb_add(&bar[XB_XSUB(b.x)], 1u);
    const unsigned gen = old / nloc;
    if (old + 1u == (gen + 1u) * nloc) {
      __builtin_amdgcn_fence(__ATOMIC_RELEASE, "agent");
      asm volatile("s_waitcnt vmcnt(0)" ::: "memory");
      const unsigned og = xb_add(&bar[XB_TOP], 1u);
      const unsigned tg = og / nx;
      if (og + 1u == (tg + 1u) * nx) xb_add(&bar[XB_TOPGEN], 1u);
      else XB_SPIN(xb_ld(&bar[XB_TOPGEN]) == tg, bar);
      __builtin_amdgcn_fence(__ATOMIC_ACQUIRE, "agent");
      xb_add(&bar[XB_XGEN(b.x)], 1u);
      asm volatile("s_waitcnt vmcnt(0)" ::: "memory");
    } else {
      XB_SPIN(xb_ld(&bar[XB_XGEN(b.x)]) == gen, bar);
      __builtin_amdgcn_fence(__ATOMIC_ACQUIRE, "agent");
      asm volatile("s_waitcnt vmcnt(0)" ::: "memory");
    }
  }
  __syncthreads();
}
DI void lds_barrier() { asm volatile("s_waitcnt lgkmcnt(0)\n\ts_barrier" ::: "memory"); }

DI void phase0a(const Params& p) {
  float* CST = (float*)(p.ws + WS_CST);
  for (int idx = blockIdx.x * 256 + otid(); idx < 1024 * 160; idx += gridDim.x * 256) {
    const int k = idx / 160, r = idx - k * 160;
    float v = 0.f;
    if (r < 8) v = silu(p.c_p[r * 1024 + k]); else if (r < 136) v = silu(p.c_s[(r - 8) * 1024 + k]);
    CST[idx] = v;
  }
}
DI void phase0(const Params& p, char* smem) {
  float* MOD = (float*)(p.ws + WS_MOD);
  const float* CST = (const float*)(p.ws + WS_CST);
  const int nmod = gridDim.x >= 384 ? 192 : 0;
  const int tstep = gridDim.x - nmod;
  if (nmod == 0 || (int)blockIdx.x < nmod)
  for (int task = blockIdx.x; task < 192; task += gridDim.x) {
    int tid = threadIdx.x; asm volatile("" : "+v"(tid));
    {
      const int l = task / 96, cb = task % 96;
      const int lane = tid & 63, wave = tid >> 6;
      float* red = (float*)smem;
      __syncthreads();
      for (int i = tid; i < 160 * 32; i += 256) red[i] = 0.f;
      __syncthreads();
      f32x16 acc[5];
#pragma unroll
      for (int mt = 0; mt < 5; ++mt)
#pragma unroll
        for (int i = 0; i < 16; ++i) acc[mt][i] = 0.f;
      const float* wm = p.w_mod + (size_t)l * 1024 * 3072 + cb * 32 + (lane & 31) + (size_t)(wave * 256 + (lane >> 5)) * 3072;
      const float* ct = CST + (lane & 31) + (wave * 256 + (lane >> 5)) * 160;
      float bA[8], aA[8][5], bB[8], aB[8][5];
#define MOD_LOAD(bb, aa, g) { _Pragma("unroll") for (int u = 0; u < 8; ++u) { const int kk = 2 * ((g) * 8 + u); bb[u] = wm[(size_t)kk * 3072]; _Pragma("unroll") for (int mt = 0; mt < 5; ++mt) aa[u][mt] = ct[kk * 160 + mt * 32]; } }
#define MOD_COMP(bb, aa) { _Pragma("unroll") for (int u = 0; u < 8; ++u) { _Pragma("unroll") for (int mt = 0; mt < 5; ++mt) acc[mt] = __builtin_amdgcn_mfma_f32_32x32x2f32(aa[u][mt], bb[u], acc[mt], 0, 0, 0); } }
      MOD_LOAD(bA, aA, 0);
#pragma unroll 1
      for (int g = 0; g < 16; g += 2) {
        MOD_LOAD(bB, aB, g + 1);
        MOD_COMP(bA, aA);
        { const int g2 = g + 2 < 16 ? g + 2 : 15; MOD_LOAD(bA, aA, g2); }
        MOD_COMP(bB, aB);
      }
#pragma unroll
      for (int mt = 0; mt < 5; ++mt)
#pragma unroll
        for (int i = 0; i < 16; ++i) atomicAdd(&red[(mt * 32 + rowi(i, lane)) * 32 + (lane & 31)], acc[mt][i]);
      __syncthreads();
      {
        const int col = tid & 31;
        const float bm = p.b_mod[l * 3072 + cb * 32 + col];
        for (int r = tid >> 5; r < 136; r += 8) MOD[((size_t)l * 136 + r) * 3072 + cb * 32 + col] = red[r * 32 + col] + bm;
      }
    }
  }
  if ((int)blockIdx.x >= nmod) {
    {
      const int tid = threadIdx.x;
      const int TOT = (4096 + 1024 + 4224 + 1024) * 128;
      const int nthr = tstep * 256;
      for (int it0 = ((int)blockIdx.x - nmod) * 256 + tid; it0 < TOT; it0 += 2 * nthr) {
        float v[2][8]; bf16_t* dptr[2]; bool ok[2];
#pragma unroll
        for (int u = 0; u < 2; ++u) {
          int it = it0 + u * nthr; ok[u] = it < TOT; if (!ok[u]) it = it0;
          const float* src; int ldw, N, mode; bf16_t* dst;
          if (it < 4096 * 128) { src = p.wa_in; ldw = 4096; N = 4096; mode = 1; dst = (bf16_t*)(p.ws + WS_WT1); }
          else if (it < 5120 * 128) { it -= 4096 * 128; src = p.wa_out; ldw = 1024; N = 1024; mode = 0; dst = (bf16_t*)(p.ws + WS_WT2); }
          else if (it < 9344 * 128) { it -= 5120 * 128; src = p.wb_in; ldw = 4112; N = 4224; mode = 2; dst = (bf16_t*)(p.ws + WS_WT3); }
          else { it -= 9344 * 128; src = p.wb_out; ldw = 1024; N = 1024; mode = 0; dst = (bf16_t*)(p.ws + WS_WT4); }
          const int k8 = it / N, np = it - k8 * N;
          int sc = np;
          if (mode == 1) { const int nt128 = np >> 7, seg = (np >> 5) & 3, j = np & 31; sc = (seg == 0 ? 1024 : seg == 1 ? 2048 : seg == 2 ? 0 : 3072) + nt128 * 32 + j; }
          const bool valid = !(mode == 2 && np >= 4112);
          const float* sp = src + (size_t)(k8 * 8) * ldw + (valid ? sc : 0);
#pragma unroll
          for (int j = 0; j < 8; ++j) { const float x = sp[(size_t)j * ldw]; v[u][j] = valid ? x : 0.f; }
          dptr[u] = dst + ((size_t)((np >> 5) * 64 + (k8 >> 1)) * 64 + (np & 31) + 32 * (k8 & 1)) * 8;
        }
#pragma unroll
        for (int u = 0; u < 2; ++u) if (ok[u]) {
          u32x4 o; o[0] = pk2(v[u][0], v[u][1]); o[1] = pk2(v[u][2], v[u][3]); o[2] = pk2(v[u][4], v[u][5]); o[3] = pk2(v[u][6], v[u][7]);
          *(u32x4*)dptr[u] = o;
        }
      }
    }
  }
}

DI void phase1(const Params& p) {
  const float* MOD = (const float*)(p.ws + WS_MOD);
  bf16_t* AB = (bf16_t*)(p.ws + WS_ABUF);
  for (int i = blockIdx.x * 256 + otid(); i < MTOT * 128; i += gridDim.x * 256) {
    const int row = i >> 7, c8 = (i & 127) * 8;
    const float* xr = xrow(p, row) + c8;
    const float* md = MOD + (size_t)bidx(row) * 3072 + c8;
    const f32x4 x0 = *(const f32x4*)xr, x1 = *(const f32x4*)(xr + 4);
    const f32x4 sh0 = *(const f32x4*)md, sh1 = *(const f32x4*)(md + 4), sc0 = *(const f32x4*)(md + 1024), sc1 = *(const f32x4*)(md + 1028);
    u32x4 o;
    o[0] = pk2(x0[0] * (1.f + sc0[0]) + sh0[0], x0[1] * (1.f + sc0[1]) + sh0[1]);
    o[1] = pk2(x0[2] * (1.f + sc0[2]) + sh0[2], x0[3] * (1.f + sc0[3]) + sh0[3]);
    o[2] = pk2(x1[0] * (1.f + sc1[0]) + sh1[0], x1[1] * (1.f + sc1[1]) + sh1[1]);
    o[3] = pk2(x1[2] * (1.f + sc1[2]) + sh1[2], x1[3] * (1.f + sc1[3]) + sh1[3]);
    *(u32x4*)(AB + (size_t)row * 1024 + c8) = o;
  }
}

template <int MI, class Epi>
DI void gemm_phase(const bf16_t* __restrict__ A, const bf16_t* __restrict__ Bt, const int ntN, char* smem, const Epi& epi) {
  constexpr int BM = 64 * MI;
  bf16_t* sA = (bf16_t*)smem;
  const int ntiles = (MTOT / BM) * ntN;
  for (int t = blockIdx.x; t < ntiles; t += gridDim.x) {
    const int tid = otid(), lane = tid & 63, wave = tid >> 6, wr = wave >> 1, wc = wave & 1;
    const int lrow = tid >> 3, lkc = (tid & 7) * 8;
    const int mt = t / ntN, nt = t - mt * ntN;
    const bf16_t* Ag = A + ((size_t)mt * BM + lrow) * 1024 + lkc;
    const bf16_t* Bf = Bt + (size_t)(nt * 4 + wc * 2) * 64 * 512 + lane * 8;
    f32x16 acc[MI][2];
#pragma unroll
    for (int mi = 0; mi < MI; ++mi)
#pragma unroll
      for (int nj = 0; nj < 2; ++nj)
#pragma unroll
        for (int i = 0; i < 16; ++i) acc[mi][nj][i] = 0.f;
    typename Epi::Pre pre;
    epi.prefetch(mt * BM + wr * (32 * MI), nt, wc, lane, pre);
    u32x4 ra[2 * MI];
    bf16x8 bfr[2][4];
#pragma unroll
    for (int q = 0; q < 2 * MI; ++q) ra[q] = *(const u32x4*)(Ag + (size_t)q * 32 * 1024);
#pragma unroll
    for (int nj = 0; nj < 2; ++nj)
#pragma unroll
      for (int ks = 0; ks < 4; ++ks) bfr[nj][ks] = *(const bf16x8*)(Bf + (size_t)(nj * 64 + ks) * 512);
    for (int kt = 0; kt < 16; ++kt) {
      lds_barrier();
#pragma unroll
      for (int q = 0; q < 2 * MI; ++q) *(u32x4*)(sA + (lrow + 32 * q) * 72 + lkc) = ra[q];
      lds_barrier();
      const int kn = kt < 15 ? kt + 1 : 15;
#pragma unroll
      for (int q = 0; q < 2 * MI; ++q) ra[q] = *(const u32x4*)(Ag + (size_t)q * 32 * 1024 + kn * 64);
      __builtin_amdgcn_sched_barrier(0);
      __builtin_amdgcn_s_setprio(2);
#pragma unroll
      for (int ks = 0; ks < 4; ++ks) {
        bf16x8 a[MI];
#pragma unroll
        for (int mi = 0; mi < MI; ++mi) a[mi] = *(const bf16x8*)(sA + (wr * (32 * MI) + mi * 32 + (lane & 31)) * 72 + ks * 16 + (lane >> 5) * 8);
#pragma unroll
        for (int mi = 0; mi < MI; ++mi)
#pragma unroll
          for (int nj = 0; nj < 2; ++nj) acc[mi][nj] = MFMA32(a[mi], bfr[nj][ks], acc[mi][nj]);
#pragma unroll
        for (int nj = 0; nj < 2; ++nj) bfr[nj][ks] = *(const bf16x8*)(Bf + (size_t)(nj * 64 + kn * 4 + ks) * 512);
      }
      __builtin_amdgcn_s_setprio(0);
    }
    epi(mt * BM + wr * (32 * MI), nt, wc, lane, acc, pre);
  }
}

DI unsigned pair_pk(float v0, float v1, int lane) {
  const bool odd = lane & 1;
  const float send = odd ? v0 : v1;
  const float recv = __builtin_bit_cast(float, __builtin_amdgcn_update_dpp(0, __builtin_bit_cast(int, send), 0xB1, 0xF, 0xF, true));
  return odd ? pk2(recv, v1) : pk2(v0, recv);
}
template <int MI> struct Epi1 {
  struct Pre {};
  DI void prefetch(int, int, int, int, Pre&) const {}
  bf16_t* CH; bf16_t* G1; float* out;
  template <bool TAIL> DI void body(int row0, int nt, int wc, int lane, const f32x16 (&acc)[MI][2]) const {
    const int ch = nt * 32 + (lane & 31);
    bf16_t* dst = (wc == 0 ? CH : G1) + (ch & ~1);
#pragma unroll
    for (int mi = 0; mi < MI; ++mi)
#pragma unroll
      for (int ip = 0; ip < 8; ++ip) {
        float v[2];
#pragma unroll
        for (int u = 0; u < 2; ++u) {
          const int i = 2 * ip + u;
          v[u] = wc == 0 ? acc[mi][0][i] * acc[mi][1][i] : acc[mi][0][i] * silu(acc[mi][1][i]);
          if (TAIL && wc == 0) {
            const int row = row0 + mi * 32 + rowi(i, lane);
            if (row < MP) { const int t = row & 2047; if (t >= 2046) out[OUT_CAP + (size_t)((row >> 11) * 2 + (t - 2046)) * 1024 + ch] = v[u]; }
            else { const int t = row & 7; if (t >= 6) out[OUT_CAS + (size_t)(((row - MP) >> 3) * 2 + (t - 6)) * 1024 + ch] = v[u]; }
          }
        }
        const int row = row0 + mi * 32 + rowi(2 * ip + (lane & 1), lane);
        *(unsigned*)(dst + (size_t)row * 1024) = pair_pk(v[0], v[1], lane);
      }
  }
  DI void operator()(int row0, int nt, int wc, int lane, const f32x16 (&acc)[MI][2], const Pre& pre) const {
    const bool tail = row0 >= MP || ((row0 + 32 * MI - 1) & 2047) >= 2046;
    if (tail) body<true>(row0, nt, wc, lane, acc); else body<false>(row0, nt, wc, lane, acc);
  }
};
template <int MI> struct Epi2 {
  Params p;
  struct Pre { float v[MI][2][16]; };
  DI void prefetch(int row0, int nt, int wc, int lane, Pre& pre) const {
    const float* base = xrow(p, row0 + 4 * (lane >> 5)) + nt * 128 + wc * 64 + (lane & 31);
#pragma unroll
    for (int mi = 0; mi < MI; ++mi)
#pragma unroll
      for (int i = 0; i < 16; ++i)
#pragma unroll
        for (int nj = 0; nj < 2; ++nj) pre.v[mi][nj][i] = base[(mi * 32 + (i & 3) + 8 * (i >> 2)) * 1024 + nj * 32];
  }
  template <bool PROMPT> DI void body(int row0, int nt, int wc, int lane, const f32x16 (&acc)[MI][2], const Pre& pre) const {
    const float* MOD = (const float*)(p.ws + WS_MOD);
    const int c0 = nt * 128 + wc * 64 + (lane & 31);
    float g0 = 0.f, g1 = 0.f;
    if (PROMPT) { const float* gt = MOD + (size_t)(row0 >> 11) * 3072 + 2048 + c0; g0 = gt[0]; g1 = gt[32]; }
#pragma unroll
    for (int mi = 0; mi < MI; ++mi)
#pragma unroll
      for (int i = 0; i < 16; ++i) {
        const int row = row0 + mi * 32 + rowi(i, lane);
        if (!PROMPT) { const float* gt = MOD + (size_t)bidx(row) * 3072 + 2048 + c0; g0 = gt[0]; g1 = gt[32]; }
        float* yp = p.out + OUT_Y + (size_t)row * 1024 + c0;
        yp[0] = ALPHA_F * pre.v[mi][0][i] + g0 * acc[mi][0][i];
        yp[32] = ALPHA_F * pre.v[mi][1][i] + g1 * acc[mi][1][i];
      }
  }
  DI void operator()(int row0, int nt, int wc, int lane, const f32x16 (&acc)[MI][2], const Pre& pre) const {
    if (row0 < MP) body<true>(row0, nt, wc, lane, acc, pre); else body<false>(row0, nt, wc, lane, acc, pre);
  }
};
template <int MI> struct Epi3 {
  Params p;
  struct Pre {};
  DI void prefetch(int, int, int, int, Pre&) const {}
  template <bool TAIL> DI void body(int row0, int nt, int wc, int lane, const f32x16 (&acc)[MI][2]) const {
    bf16_t* QKV = (bf16_t*)(p.ws + WS_QKV); bf16_t* Z = (bf16_t*)(p.ws + WS_Z); float* BA = (float*)(p.ws + WS_BA);
    if (nt < 32) {
#pragma unroll
      for (int nj = 0; nj < 2; ++nj) {
        const int col = nt * 128 + wc * 64 + nj * 32 + (lane & 31);
        bf16_t* dst = nt < 24 ? QKV + (col & ~1) : Z + ((col - 3072) & ~1);
        const int ld = nt < 24 ? 3072 : 1024;
#pragma unroll
        for (int mi = 0; mi < MI; ++mi)
#pragma unroll
          for (int ip = 0; ip < 8; ++ip) {
            if (TAIL && nt < 24) {
#pragma unroll
              for (int u = 0; u < 2; ++u) {
                const int row = row0 + mi * 32 + rowi(2 * ip + u, lane);
                const float v = acc[mi][nj][2 * ip + u];
                if (row < MP) { const int t = row & 2047; if (t >= 2045) p.out[OUT_CBP + (size_t)((row >> 11) * 3 + (t - 2045)) * 3072 + col] = v; }
                else { const int t = row & 7; if (t >= 5) p.out[OUT_CBS + (size_t)(((row - MP) >> 3) * 3 + (t - 5)) * 3072 + col] = v; }
              }
            }
            const int row = row0 + mi * 32 + rowi(2 * ip + (lane & 1), lane);
            *(unsigned*)(dst + (size_t)row * ld) = pair_pk(acc[mi][nj][2 * ip], acc[mi][nj][2 * ip + 1], lane);
          }
      }
    } else if (wc == 0 && (lane & 31) < 16) {
#pragma unroll
      for (int mi = 0; mi < MI; ++mi)
#pragma unroll
        for (int i = 0; i < 16; ++i) BA[(size_t)(row0 + mi * 32 + rowi(i, lane)) * 16 + (lane & 31)] = acc[mi][0][i];
    }
  }
  DI void operator()(int row0, int nt, int wc, int lane, const f32x16 (&acc)[MI][2], const Pre& pre) const {
    const bool tail = row0 >= MP || ((row0 + 32 * MI - 1) & 2047) >= 2045;
    if (tail) body<true>(row0, nt, wc, lane, acc); else body<false>(row0, nt, wc, lane, acc);
  }
};
template <int MI> struct Epi4 {
  Params p;
  struct Pre { float v[MI][2][16]; };
  DI void prefetch(int row0, int nt, int wc, int lane, Pre& pre) const {
    const float* base = p.out + OUT_Y + (size_t)(row0 + 4 * (lane >> 5)) * 1024 + nt * 128 + wc * 64 + (lane & 31);
#pragma unroll
    for (int mi = 0; mi < MI; ++mi)
#pragma unroll
      for (int i = 0; i < 16; ++i)
#pragma unroll
        for (int nj = 0; nj < 2; ++nj) pre.v[mi][nj][i] = base[(mi * 32 + (i & 3) + 8 * (i >> 2)) * 1024 + nj * 32];
  }
  template <bool PROMPT> DI void body(int row0, int nt, int wc, int lane, const f32x16 (&acc)[MI][2], const Pre& pre) const {
    const float* MOD = (const float*)(p.ws + WS_MOD) + (size_t)136 * 3072;
    const float* ST = (const float*)(p.ws + WS_STATS);
    const int c0 = nt * 128 + wc * 64 + (lane & 31);
    const float lg0 = p.ln_g[c0], lg1 = p.ln_g[c0 + 32], lb0 = p.ln_b[c0], lb1 = p.ln_b[c0 + 32];
    float g0 = 0.f, g1 = 0.f;
    if (PROMPT) { const float* gt = MOD + (size_t)(row0 >> 11) * 3072 + 2048 + c0; g0 = gt[0]; g1 = gt[32]; }
#pragma unroll
    for (int mi = 0; mi < MI; ++mi)
#pragma unroll
      for (int i = 0; i < 16; ++i) {
        const int row = row0 + mi * 32 + rowi(i, lane);
        const float mu = ST[row * 2], rstd = ST[row * 2 + 1];
        if (!PROMPT) { const float* gt = MOD + (size_t)bidx(row) * 3072 + 2048 + c0; g0 = gt[0]; g1 = gt[32]; }
        float* yp = p.out + OUT_Y + (size_t)row * 1024 + c0;
        yp[0] = ALPHA_F * ((pre.v[mi][0][i] - mu) * rstd * lg0 + lb0) + g0 * acc[mi][0][i];
        yp[32] = ALPHA_F * ((pre.v[mi][1][i] - mu) * rstd * lg1 + lb1) + g1 * acc[mi][1][i];
      }
  }
  DI void operator()(int row0, int nt, int wc, int lane, const f32x16 (&acc)[MI][2], const Pre& pre) const {
    if (row0 < MP) body<true>(row0, nt, wc, lane, acc, pre); else body<false>(row0, nt, wc, lane, acc, pre);
  }
};

DI void phase3(const Params& p) {
  const bf16_t* CH = (const bf16_t*)(p.ws + WS_CH); const bf16_t* G1 = (const bf16_t*)(p.ws + WS_G1);
  bf16_t* AB = (bf16_t*)(p.ws + WS_ABUF);
  for (int i = blockIdx.x * 256 + otid(); i < MTOT * 128; i += gridDim.x * 256) {
    const int row = i >> 7, c8 = (i & 127) * 8;
    const bool smp = row >= MP;
    const int t = smp ? (row & 7) : (row & 2047);
    float cur[8], p1[8], p2[8], g[8];
    { const u32x4 r = *(const u32x4*)(CH + (size_t)row * 1024 + c8);
#pragma unroll
      for (int e = 0; e < 4; ++e) { cur[2 * e] = bflo(r[e]); cur[2 * e + 1] = bfhi(r[e]); } }
    { const u32x4 r = *(const u32x4*)(G1 + (size_t)row * 1024 + c8);
#pragma unroll
      for (int e = 0; e < 4; ++e) { g[2 * e] = bflo(r[e]); g[2 * e + 1] = bfhi(r[e]); } }
    if (t >= 1) { const u32x4 r = *(const u32x4*)(CH + (size_t)(row - 1) * 1024 + c8);
#pragma unroll
      for (int e = 0; e < 4; ++e) { p1[2 * e] = bflo(r[e]); p1[2 * e + 1] = bfhi(r[e]); } }
    else if (smp) { const float* b = p.st_conv_a + ((size_t)((row - MP) >> 3) * 2 + 1) * 1024 + c8;
#pragma unroll
      for (int e = 0; e < 8; ++e) p1[e] = b[e]; }
    else {
#pragma unroll
      for (int e = 0; e < 8; ++e) p1[e] = 0.f; }
    if (t >= 2) { const u32x4 r = *(const u32x4*)(CH + (size_t)(row - 2) * 1024 + c8);
#pragma unroll
      for (int e = 0; e < 4; ++e) { p2[2 * e] = bflo(r[e]); p2[2 * e + 1] = bfhi(r[e]); } }
    else if (smp) { const float* b = p.st_conv_a + ((size_t)((row - MP) >> 3) * 2 + t) * 1024 + c8;
#pragma unroll
      for (int e = 0; e < 8; ++e) p2[e] = b[e]; }
    else {
#pragma unroll
      for (int e = 0; e < 8; ++e) p2[e] = 0.f; }
    float o[8];
#pragma unroll
    for (int e = 0; e < 8; ++e) o[e] = g[e] * (p.wa_conv[c8 + e] * p2[e] + p.wa_conv[1024 + c8 + e] * p1[e] + p.wa_conv[2048 + c8 + e] * cur[e]);
    u32x4 ov; ov[0] = pk2(o[0], o[1]); ov[1] = pk2(o[2], o[3]); ov[2] = pk2(o[4], o[5]); ov[3] = pk2(o[6], o[7]);
    *(u32x4*)(AB + (size_t)row * 1024 + c8) = ov;
  }
}

template <int FINAL>
DI void ln_phase(const Params& p) {
  const int tid0 = otid();
  const int lane = tid0 & 63;
  const int gw = blockIdx.x * 4 + (tid0 >> 6), nw = gridDim.x * 4;
  const float* MOD1 = (const float*)(p.ws + WS_MOD) + (size_t)136 * 3072;
  float* ST = (float*)(p.ws + WS_STATS);
  bf16_t* AB = (bf16_t*)(p.ws + WS_ABUF);
  const float* lg = p.ln_g + (FINAL ? 1024 : 0); const float* lb = p.ln_b + (FINAL ? 1024 : 0);
  for (int row = gw; row < MTOT; row += nw) {
    float* yr = p.out + OUT_Y + (size_t)row * 1024;
    f32x4 v[4];
    float s = 0.f;
#pragma unroll
    for (int j = 0; j < 4; ++j) { v[j] = *(const f32x4*)(yr + j * 256 + lane * 4); s += v[j][0] + v[j][1] + v[j][2] + v[j][3]; }
#pragma unroll
    for (int o = 32; o >= 1; o >>= 1) s += __shfl_xor(s, o);
    const float mu = s * (1.f / 1024.f);
    float q = 0.f;
#pragma unroll
    for (int j = 0; j < 4; ++j)
#pragma unroll
      for (int e = 0; e < 4; ++e) { const float d = v[j][e] - mu; q += d * d; }
#pragma unroll
    for (int o = 32; o >= 1; o >>= 1) q += __shfl_xor(q, o);
    const float rstd = rsqrtf(q * (1.f / 1024.f) + 1e-5f);
    if (!FINAL && lane == 0) { ST[row * 2] = mu; ST[row * 2 + 1] = rstd; }
    const float* md = MOD1 + (size_t)bidx(row) * 3072;
#pragma unroll
    for (int j = 0; j < 4; ++j) {
      const int col = j * 256 + lane * 4;
      const f32x4 g4 = *(const f32x4*)(lg + col), b4 = *(const f32x4*)(lb + col);
      f32x4 x1;
#pragma unroll
      for (int e = 0; e < 4; ++e) x1[e] = (v[j][e] - mu) * rstd * g4[e] + b4[e];
      if (FINAL) { __builtin_nontemporal_store(x1, (f32x4*)(yr + col)); }
      else {
        const f32x4 sh = *(const f32x4*)(md + col), sc = *(const f32x4*)(md + 1024 + col);
        u32x2 o; o[0] = pk2(x1[0] * (1.f + sc[0]) + sh[0], x1[1] * (1.f + sc[1]) + sh[1]); o[1] = pk2(x1[2] * (1.f + sc[2]) + sh[2], x1[3] * (1.f + sc[3]) + sh[3]);
        *(u32x2*)(AB + (size_t)row * 1024 + col) = o;
      }
    }
  }
}

DI void gdn_chunk_local(const Params& p, char* smem0) {
  for (int task = blockIdx.x; task < 2048; task += gridDim.x) {
  int tid = threadIdx.x; asm volatile("" : "+v"(tid));
  int off0 = 0; asm volatile("" : "+v"(off0));
  char* smem = (char*)__builtin_assume_aligned(smem0 + (off0 & ~15), 16);
  const int lane = tid & 63, wave = __builtin_amdgcn_readfirstlane(tid >> 6);
  bf16_t* sq = (bf16_t*)smem;
  bf16_t* sk = sq + 64 * 136;
  bf16_t* sv = sk + 64 * 136;
  float* sAm = (float*)(smem + 3 * 17408);
  float* sc = (float*)(smem + 4 * 17408);
  float *sG = sc, *sBeta = sc + 64, *sRq = sc + 128, *sRk = sc + 192, *sSsq = sc + 256, *sSsk = sc + 320, *sBk = sc + 384, *sEg = sc + 448, *sKt = sc + 512;
  const bf16_t* QKV = (const bf16_t*)(p.ws + WS_QKV);
  const float* BA = (const float*)(p.ws + WS_BA);
  float* GL = (float*)(p.ws + WS_GL);
  bf16_t* Ug = (bf16_t*)(p.ws + WS_U); bf16_t* Wg = (bf16_t*)(p.ws + WS_W); bf16_t* ATT = (bf16_t*)(p.ws + WS_ATTN);
  bf16_t* QG = (bf16_t*)(p.out + OUT_SSS); bf16_t* KT = QG + (size_t)2048 * 8192;
  {
    const int n = task & 31, h = (task >> 5) & 7, b = task >> 8;
    const int row0 = b * 2048 + n * 64;
    {
      const int cg16 = tid & 15, rsub = tid >> 4;
      u32x4 raw[3][7];
#pragma unroll
      for (int seg = 0; seg < 3; ++seg)
#pragma unroll
        for (int r7 = 0; r7 < 7; ++r7) {
          const int ii = rsub * 4 - 3 + r7;
          if (n * 64 + ii >= 0) raw[seg][r7] = *(const u32x4*)(QKV + (size_t)(row0 + ii) * 3072 + seg * 1024 + h * 128 + cg16 * 8);
          else { raw[seg][r7][0] = 0u; raw[seg][r7][1] = 0u; raw[seg][r7][2] = 0u; raw[seg][r7][3] = 0u; }
        }
#pragma unroll
      for (int seg = 0; seg < 3; ++seg) {
        const int colbase = seg * 1024 + h * 128 + cg16 * 8;
        float wt[4][8];
#pragma unroll
        for (int j = 0; j < 4; ++j) {
          const f32x4 w0 = *(const f32x4*)(p.wb_conv + j * 3072 + colbase), w1 = *(const f32x4*)(p.wb_conv + j * 3072 + colbase + 4);
#pragma unroll
          for (int e = 0; e < 4; ++e) { wt[j][e] = w0[e]; wt[j][4 + e] = w1[e]; }
        }
        bf16_t* dst = sq + seg * (64 * 136);
#pragma unroll
        for (int o4 = 0; o4 < 4; ++o4) {
          const int i = rsub * 4 + o4;
          float a8[8];
#pragma unroll
          for (int e = 0; e < 8; ++e) a8[e] = 0.f;
#pragma unroll
          for (int j = 0; j < 4; ++j) {
#pragma unroll
            for (int e = 0; e < 4; ++e) { a8[2 * e] += wt[j][2 * e] * bflo(raw[seg][o4 + j][e]); a8[2 * e + 1] += wt[j][2 * e + 1] * bfhi(raw[seg][o4 + j][e]); }
          }
          float ss = 0.f;
#pragma unroll
          for (int e = 0; e < 8; ++e) { a8[e] = silu(a8[e]); ss += a8[e] * a8[e]; }
          u32x4 o; o[0] = pk2(a8[0], a8[1]); o[1] = pk2(a8[2], a8[3]); o[2] = pk2(a8[4], a8[5]); o[3] = pk2(a8[6], a8[7]);
          *(u32x4*)(dst + i * 136 + cg16 * 8) = o;
          if (seg < 2) {
#pragma unroll
            for (int o2 = 8; o2 >= 1; o2 >>= 1) ss += __shfl_xor(ss, o2);
            if (cg16 == 0) sSsq[seg * 64 + i] = ss;
          }
        }
      }
    }
    __syncthreads();
    if (tid < 64) {
      const int row = row0 + tid;
      const float bb = BA[(size_t)row * 16 + h], aa = BA[(size_t)row * 16 + 8 + h];
      const float beta = 1.f / (1.f + expf(-bb));
      const float xx = aa + p.wb_dt_bias[h];
      const float sp = xx > 20.f ? xx : log1pf(expf(xx));
      const float g = -expf(p.wb_a_log[h]) * sp;
      float G = g;
#pragma unroll
      for (int off = 1; off < 64; off <<= 1) { const float tv = __shfl_up(G, off); if (lane >= off) G += tv; }
      const float Gl = __shfl(G, 63);
      const float rk = rsqrtf(sSsk[tid] + 1e-6f), rq = rsqrtf(sSsq[tid] + 1e-6f) * 0.08838834764831845f;
      const float eg = expf(G);
      sG[tid] = G; sBeta[tid] = beta; sRq[tid] = rq * eg; sRk[tid] = rk; sBk[tid] = rk * beta * eg; sEg[tid] = rq; sKt[tid] = rk * expf(Gl - G);
      if (tid == 63) GL[task] = eg;
    }
    __syncthreads();
    {
      bf16_t* qgo = QG + (size_t)task * 8192; bf16_t* kto = KT + (size_t)task * 8192;
#pragma unroll
      for (int c4 = 0; c4 < 4; ++c4) {
        const int o = tid + 256 * c4;
        {
          const int mt = o >> 9, s = (o >> 6) & 7, ln = o & 63, i = mt * 32 + (ln & 31), hh = ln >> 5;
          const u32x2 lo = *(const u32x2*)(sq + i * 136 + s * 16 + hh * 4), hi = *(const u32x2*)(sq + i * 136 + s * 16 + 8 + hh * 4);
          const float f = sRq[i];
          u32x4 ov; ov[0] = pk2(bflo(lo[0]) * f, bfhi(lo[0]) * f); ov[1] = pk2(bflo(lo[1]) * f, bfhi(lo[1]) * f);
          ov[2] = pk2(bflo(hi[0]) * f, bfhi(hi[0]) * f); ov[3] = pk2(bflo(hi[1]) * f, bfhi(hi[1]) * f);
          *(u32x4*)(qgo + (size_t)o * 8) = ov;
        }
        {
          const int mt = o >> 8, s = (o >> 6) & 3, ln = o & 63, m = mt * 32 + (ln & 31), hh = ln >> 5;
          float vv[8];
#pragma unroll
          for (int e = 0; e < 8; ++e) { const int j = s * 16 + (e >> 2) * 8 + hh * 4 + (e & 3); vv[e] = bf2f(sk[j * 136 + m]) * sKt[j]; }
          u32x4 ov; ov[0] = pk2(vv[0], vv[1]); ov[1] = pk2(vv[2], vv[3]); ov[2] = pk2(vv[4], vv[5]); ov[3] = pk2(vv[6], vv[7]);
          *(u32x4*)(kto + (size_t)o * 8) = ov;
        }
      }
    }
    const int mat = wave >> 1, gmi = wave & 1;
    f32x16 g2[2];
#pragma unroll
    for (int nj = 0; nj < 2; ++nj)
#pragma unroll
      for (int i = 0; i < 16; ++i) g2[nj][i] = 0.f;
    {
      const bf16_t* srcA = mat ? sq : sk;
#pragma unroll
      for (int ks = 0; ks < 8; ++ks) {
        const bf16x8 a = *(const bf16x8*)(srcA + (gmi * 32 + (lane & 31)) * 136 + ks * 16 + (lane >> 5) * 8);
#pragma unroll
        for (int nj = 0; nj < 2; ++nj) {
          const bf16x8 bb = *(const bf16x8*)(sk + (nj * 32 + (lane & 31)) * 136 + ks * 16 + (lane >> 5) * 8);
          g2[nj] = MFMA32(a, bb, g2[nj]);
        }
      }
    }
    __syncthreads();
#pragma unroll
    for (int nj = 0; nj < 2; ++nj)
#pragma unroll
      for (int r = 0; r < 16; ++r) {
        const int i = gmi * 32 + rowi(r, lane), j = nj * 32 + (lane & 31);
        const float dec = __expf(fminf(sG[i] - sG[j], 0.f));
        if (mat == 0) {
          sAm[i * 68 + j] = (i > j) ? sBeta[i] * sRk[i] * sRk[j] * dec * g2[nj][r] : 0.f;
        } else {
          const float val = (i >= j) ? sEg[i] * sRk[j] * dec * g2[nj][r] : 0.f;
          const int s = j >> 4, q = j & 15, e = (q >> 3) * 4 + (q & 3), hh = (q >> 2) & 1, ln = (i & 31) + 32 * hh;
          sq[((gmi * 4 + s) * 64 + ln) * 8 + e] = (bf16_t)f2bf(val);
        }
      }
    __syncthreads();
#pragma unroll
    for (int c = 0; c < 2; ++c) { const int o = tid + 256 * c; *(u32x4*)(ATT + (size_t)task * 4096 + (size_t)o * 8) = *(const u32x4*)(sq + o * 8); }
    typedef float f32x2 __attribute__((ext_vector_type(2)));
    f32x2 xv[32];
    {
      const bool isV = tid < 128;
      const bf16_t* src = isV ? (sv + tid) : (sk + (tid - 128));
      const float* scl = isV ? sBeta : sBk;
#pragma unroll
      for (int i = 0; i < 64; ++i) {
        f32x2 r0 = {bf2f(src[i * 136]) * scl[i], 0.f}, r1 = {0.f, 0.f};
#pragma unroll
        for (int m = 0; m < i / 2; ++m) {
          const f32x2 a2 = *(const f32x2*)(sAm + i * 68 + 2 * m);
          if (m & 1) r1 -= a2 * xv[m]; else r0 -= a2 * xv[m];
        }
        r0 += r1;
        float r = r0[0] + r0[1];
        if (i & 1) r -= sAm[i * 68 + i - 1] * xv[i / 2][0];
        xv[i / 2][i & 1] = r;
      }
    }
#define XS(i) xv[(i) >> 1][(i) & 1]
    __syncthreads();
    if (tid < 128) {
      const int s = tid >> 5, nn = tid & 31;
#pragma unroll
      for (int i = 0; i < 64; ++i) {
        const int mt = i >> 5, ii = i & 31, hh = (ii >> 2) & 1, r = (ii >> 3) * 4 + (ii & 3);
        sv[((s * 2 + mt) * 64 + nn + 32 * hh) * 16 + r] = (bf16_t)f2bf(XS(i));
      }
    } else {
      const int c = tid - 128, s = c >> 4, q = c & 15, e = (q >> 3) * 4 + (q & 3), hh = (q >> 2) & 1;
#pragma unroll
      for (int i = 0; i < 64; ++i) {
        const int mt = i >> 5;
        sk[((mt * 8 + s) * 64 + (i & 31) + 32 * hh) * 8 + e] = (bf16_t)f2bf(XS(i));
      }
    }
    __syncthreads();
#pragma unroll
    for (int c = 0; c < 4; ++c) {
      const int o = tid + 256 * c;
      *(u32x4*)(Ug + (size_t)task * 8192 + (size_t)o * 8) = *(const u32x4*)(sv + o * 8);
      *(u32x4*)(Wg + (size_t)task * 8192 + (size_t)o * 8) = *(const u32x4*)(sk + o * 8);
    }
    __syncthreads();
  }
  }
}

DI void gdn_scan(const Params& p, char* smem) {
  if (blockIdx.x >= 256) return;
  const int tid = otid(), lane = tid & 63, wave = __builtin_amdgcn_readfirstlane(tid >> 6);
  const int xcd = blockIdx.x & 7, yy = blockIdx.x >> 3;
  const int bh = xcd * 8 + (yy >> 2), s = yy & 3, h = bh & 7, b = bh >> 3;
  bf16x8* Sfrag = (bf16x8*)smem;
  bf16x8* Vfrag = Sfrag + 512;
  const bf16_t* Ug = (const bf16_t*)(p.ws + WS_U); const bf16_t* Wg = (const bf16_t*)(p.ws + WS_W); const bf16_t* ATT = (const bf16_t*)(p.ws + WS_ATTN);
  const bf16_t* QG = (const bf16_t*)(p.out + OUT_SSS); const bf16_t* KT = QG + (size_t)2048 * 8192;
  const float* GL = (const float*)(p.ws + WS_GL);
  bf16_t* O = (bf16_t*)(p.ws + WS_O);
  const size_t cbase = (size_t)(b * 8 + h) * 32;
  const bool isW = wave < 2; const int mi = wave & 1;
  f32x16 S;
#pragma unroll
  for (int i = 0; i < 16; ++i) S[i] = 0.f;
  { bf16x8 z; for (int e = 0; e < 8; ++e) z[e] = 0; for (int o = tid; o < 512; o += 256) Sfrag[o] = z; }
  const bf16_t* aBase = (isW ? Wg : QG) + cbase * 8192 + (size_t)(mi * 8) * 512 + lane * 8;
  const bf16_t* kBase = KT + cbase * 8192 + (size_t)(wave * 4) * 512 + lane * 8;
  const bf16_t* tBase = ATT + cbase * 4096 + (size_t)(mi * 4) * 512 + lane * 8;
  const bf16_t* uBase = Ug + cbase * 8192 + (size_t)((s * 2 + mi) * 64 + lane) * 16;
  struct Regs { bf16x8 afr[8], kfr[4], tfr[4]; u32x4 ur[2]; };
  const float glv = GL[cbase + (lane & 31)];
  Regs R0, R1;
  auto load_all = [&](Regs& R, int n) {
#pragma unroll
    for (int ks = 0; ks < 8; ++ks) R.afr[ks] = *(const bf16x8*)(aBase + (size_t)n * 8192 + ks * 512);
#pragma unroll
    for (int k4 = 0; k4 < 4; ++k4) { R.kfr[k4] = *(const bf16x8*)(kBase + (size_t)n * 8192 + k4 * 512); R.tfr[k4] = *(const bf16x8*)(tBase + (size_t)n * 4096 + k4 * 512); }
    R.ur[0] = *(const u32x4*)(uBase + (size_t)n * 8192); R.ur[1] = *(const u32x4*)(uBase + (size_t)n * 8192 + 8);
  };
  load_all(R0, 0);
  load_all(R1, 1);
  __syncthreads();
  auto step = [&](Regs& R, const int n) {
    const int nn = n + 2 < 32 ? n + 2 : 31;
    f32x16 acc0, acc1;
#pragma unroll
    for (int i = 0; i < 16; ++i) { acc0[i] = 0.f; acc1[i] = 0.f; }
#pragma unroll
    for (int ks = 0; ks < 8; ks += 2) {
      acc0 = MFMA32(R.afr[ks], Sfrag[ks * 64 + lane], acc0);
      acc1 = MFMA32(R.afr[ks + 1], Sfrag[(ks + 1) * 64 + lane], acc1);
    }
#pragma unroll
    for (int i = 0; i < 16; ++i) acc0[i] += acc1[i];
#pragma unroll
    for (int ks = 0; ks < 8; ++ks) R.afr[ks] = *(const bf16x8*)(aBase + (size_t)nn * 8192 + ks * 512);
    if (isW) {
      f32x16 vn;
#pragma unroll
      for (int e = 0; e < 4; ++e) {
        vn[2 * e] = bflo(R.ur[0][e]) - acc0[2 * e]; vn[2 * e + 1] = bfhi(R.ur[0][e]) - acc0[2 * e + 1];
        vn[8 + 2 * e] = bflo(R.ur[1][e]) - acc0[8 + 2 * e]; vn[8 + 2 * e + 1] = bfhi(R.ur[1][e]) - acc0[8 + 2 * e + 1];
      }
      Vfrag[(2 * mi) * 64 + lane] = pack8(vn, 0);
      Vfrag[(2 * mi + 1) * 64 + lane] = pack8(vn, 1);
      R.ur[0] = *(const u32x4*)(uBase + (size_t)nn * 8192); R.ur[1] = *(const u32x4*)(uBase + (size_t)nn * 8192 + 8);
    }
    lds_barrier();
    if (!isW) {
#pragma unroll
      for (int k4 = 0; k4 < 4; ++k4) acc0 = MFMA32(R.tfr[k4], Vfrag[k4 * 64 + lane], acc0);
      bf16_t* op = O + (size_t)(b * 2048 + n * 64 + mi * 32) * 1024 + h * 128 + s * 32 + (lane & 30);
#pragma unroll
      for (int ip = 0; ip < 8; ++ip) *(unsigned*)(op + (size_t)rowi(2 * ip + (lane & 1), lane) * 1024) = pair_pk(acc0[2 * ip], acc0[2 * ip + 1], lane);
#pragma unroll
      for (int k4 = 0; k4 < 4; ++k4) R.tfr[k4] = *(const bf16x8*)(tBase + (size_t)nn * 4096 + k4 * 512);
    }
    const float gl = __builtin_bit_cast(float, __builtin_amdgcn_readlane(__builtin_bit_cast(int, glv), n));
#pragma unroll
    for (int i = 0; i < 16; ++i) S[i] *= gl;
#pragma unroll
    for (int k4 = 0; k4 < 4; ++k4) S = MFMA32(R.kfr[k4], Vfrag[k4 * 64 + lane], S);
#pragma unroll
    for (int k4 = 0; k4 < 4; ++k4) R.kfr[k4] = *(const bf16x8*)(kBase + (size_t)nn * 8192 + k4 * 512);
    Sfrag[(2 * wave) * 64 + lane] = pack8(S, 0);
    Sfrag[(2 * wave + 1) * 64 + lane] = pack8(S, 1);
    lds_barrier();
  };
#pragma unroll 1
  for (int n = 0; n < 32; n += 2) { step(R0, n); step(R1, n + 1); }
  float* so = p.out + OUT_SSP + ((size_t)(b * 8 + h) * 128 + wave * 32) * 128 + s * 32 + (lane & 31);
#pragma unroll
  for (int r = 0; r < 16; ++r) so[(size_t)rowi(r, lane) * 128] = S[r];
}

DI void sample_task(const Params& p, char* smem, int task) {
  const int tid = otid(), lane = tid & 63, wave = tid >> 6;
  const int bs = task >> 3, h = task & 7;
  float* fq = (float*)smem; float* fk = fq + 1024; float* fv = fk + 1024; float* red = fv + 1024; float* ored = red + 2048; float* scal = ored + 2048;
  const bf16_t* QKV = (const bf16_t*)(p.ws + WS_QKV); const float* BA = (const float*)(p.ws + WS_BA);
  const bf16_t* Z = (const bf16_t*)(p.ws + WS_Z); bf16_t* AB = (bf16_t*)(p.ws + WS_ABUF);
  const int rowb = MP + bs * 8;
#pragma unroll
  for (int it = 0; it < 12; ++it) {
    const int idx = tid + 256 * it;
    const int tok = idx / 384, cc = idx - tok * 384, seg = cc >> 7, c = cc & 127, col = seg * 1024 + h * 128 + c;
    float acc = 0.f;
#pragma unroll
    for (int j = 0; j < 4; ++j) {
      const int tt = tok + j;
      const float xs = p.st_conv_b[((size_t)bs * 3 + (tt < 3 ? tt : 2)) * 3072 + col];
      const float xq = bf2f(QKV[(size_t)(rowb + (tt >= 3 ? tt - 3 : 0)) * 3072 + col]);
      acc += p.wb_conv[j * 3072 + col] * (tt < 3 ? xs : xq);
    }
    (seg == 0 ? fq : (seg == 1 ? fk : fv))[tok * 128 + c] = silu(acc);
  }
  if (tid < 8) {
    const int row = rowb + tid;
    const float bb = BA[(size_t)row * 16 + h], aa = BA[(size_t)row * 16 + 8 + h];
    const float xx = aa + p.wb_dt_bias[h];
    const float sp = xx > 20.f ? xx : log1pf(expf(xx));
    scal[tid] = 1.f / (1.f + expf(-bb));
    scal[8 + tid] = expf(-expf(p.wb_a_log[h]) * sp);
  }
  __syncthreads();
#pragma unroll
  for (int rr = 0; rr < 4; ++rr) {
    const int r16 = wave * 4 + rr;
    float* ptr = r16 < 8 ? fq + r16 * 128 : fk + (r16 - 8) * 128;
    const float a0 = ptr[lane], a1 = ptr[lane + 64];
    float ss = a0 * a0 + a1 * a1;
#pragma unroll
    for (int o = 32; o >= 1; o >>= 1) ss += __shfl_xor(ss, o);
    const float f = rsqrtf(ss + 1e-6f) * (r16 < 8 ? 0.08838834764831845f : 1.f);
    ptr[lane] = a0 * f; ptr[lane + 64] = a1 * f;
  }
  __syncthreads();
  const int vcol = tid & 127, kh = tid >> 7;
  float S[64];
  {
    const float* sp = p.st_ssm + (((size_t)bs * 8 + h) * 128 + kh * 64) * 128 + vcol;
#pragma unroll
    for (int kk = 0; kk < 64; ++kk) S[kk] = __builtin_nontemporal_load(sp + (size_t)kk * 128);
  }
#pragma unroll 1
  for (int t = 0; t < 8; ++t) {
    const float* kt = fk + t * 128 + kh * 64;
    const float* qt = fq + t * 128 + kh * 64;
    float part = 0.f;
#pragma unroll
    for (int kk = 0; kk < 64; ++kk) part += kt[kk] * S[kk];
    red[(t * 2 + kh) * 128 + vcol] = part;
    __syncthreads();
    const float kS = red[(t * 2) * 128 + vcol] + red[(t * 2 + 1) * 128 + vcol];
    const float a = scal[8 + t], be = scal[t];
    const float d = be * (fv[t * 128 + vcol] - a * kS);
    float op = 0.f;
#pragma unroll
    for (int kk = 0; kk < 64; ++kk) { S[kk] = a * S[kk] + kt[kk] * d; op += qt[kk] * S[kk]; }
    ored[(t * 2 + kh) * 128 + vcol] = op;
  }
  {
    float* so = p.out + OUT_SSS + (((size_t)bs * 8 + h) * 128 + kh * 64) * 128 + vcol;
#pragma unroll
    for (int kk = 0; kk < 64; ++kk) __builtin_nontemporal_store(S[kk], so + (size_t)kk * 128);
  }
  __syncthreads();
  {
    const int tok = tid >> 5, c4 = (tid & 31) * 4;
    float o[4]; float ss = 0.f;
#pragma unroll
    for (int e = 0; e < 4; ++e) { o[e] = ored[(tok * 2) * 128 + c4 + e] + ored[(tok * 2 + 1) * 128 + c4 + e]; ss += o[e] * o[e]; }
#pragma unroll
    for (int o2 = 16; o2 >= 1; o2 >>= 1) ss += __shfl_xor(ss, o2);
    const float rstd = rsqrtf(ss * (1.f / 128.f) + 1e-6f);
    const u32x2 zr = *(const u32x2*)(Z + (size_t)(rowb + tok) * 1024 + h * 128 + c4);
    const float z0 = bflo(zr[0]), z1 = bfhi(zr[0]), z2 = bflo(zr[1]), z3 = bfhi(zr[1]);
    u32x2 ov;
    ov[0] = pk2(o[0] * rstd * p.wb_norm[c4] * silu(z0), o[1] * rstd * p.wb_norm[c4 + 1] * silu(z1));
    ov[1] = pk2(o[2] * rstd * p.wb_norm[c4 + 2] * silu(z2), o[3] * rstd * p.wb_norm[c4 + 3] * silu(z3));
    *(u32x2*)(AB + (size_t)(rowb + tok) * 1024 + h * 128 + c4) = ov;
  }
  __syncthreads();
}

DI void phase9(const Params& p, char* smem) {
  const int tid9 = otid();
  const int lane = tid9 & 63, wave = tid9 >> 6;
  const bf16_t* O = (const bf16_t*)(p.ws + WS_O); const bf16_t* Z = (const bf16_t*)(p.ws + WS_Z); bf16_t* AB = (bf16_t*)(p.ws + WS_ABUF);
  for (int task = blockIdx.x; task < 2048; task += gridDim.x) {
    if (task < 1024) { sample_task(p, smem, task); continue; }
    const int r0 = (task - 1024) * 16 + wave * 4;
#pragma unroll
    for (int rr = 0; rr < 4; ++rr) {
      const int row = r0 + rr;
#pragma unroll
      for (int j = 0; j < 4; ++j) {
        const int col = j * 256 + lane * 4;
        const u32x2 orw = *(const u32x2*)(O + (size_t)row * 1024 + col);
        f32x4 o4; o4[0] = bflo(orw[0]); o4[1] = bfhi(orw[0]); o4[2] = bflo(orw[1]); o4[3] = bfhi(orw[1]);
        float ss = o4[0] * o4[0] + o4[1] * o4[1] + o4[2] * o4[2] + o4[3] * o4[3];
#pragma unroll
        for (int o2 = 16; o2 >= 1; o2 >>= 1) ss += __shfl_xor(ss, o2);
        const float rstd = rsqrtf(ss * (1.f / 128.f) + 1e-6f);
        const u32x2 zr = *(const u32x2*)(Z + (size_t)row * 1024 + col);
        const f32x4 nw = *(const f32x4*)(p.wb_norm + (col & 127));
        u32x2 ov;
        ov[0] = pk2(o4[0] * rstd * nw[0] * silu(bflo(zr[0])), o4[1] * rstd * nw[1] * silu(bfhi(zr[0])));
        ov[1] = pk2(o4[2] * rstd * nw[2] * silu(bflo(zr[1])), o4[3] * rstd * nw[3] * silu(bfhi(zr[1])));
        *(u32x2*)(AB + (size_t)row * 1024 + col) = ov;
      }
    }
  }
}

__global__ void __launch_bounds__(256, 2) fwd_megakernel(Params p) {
  extern __shared__ __attribute__((aligned(16))) char smem[];
  cg::grid_group grid = cg::this_grid();
  if (p.out == nullptr) grid.sync();
  __shared__ uint4 xb_words;
  if (threadIdx.x == 0) xb_words = make_uint4(0u, 0u, 0u, 0u);
  __syncthreads();
  XcdBarrier xb = xcd_barrier_post((unsigned*)(p.ws + WS_BAR), (volatile LAS unsigned*)&xb_words);
#define GSYNC() xcd_barrier(xb)
  phase0a(p);
  GSYNC();
  phase0(p, smem);
  GSYNC();
  phase1(p);
  GSYNC();
  { Epi1<4> e{(bf16_t*)(p.ws + WS_CH), (bf16_t*)(p.ws + WS_G1), p.out}; gemm_phase<4>((const bf16_t*)(p.ws + WS_ABUF), (const bf16_t*)(p.ws + WS_WT1), 32, smem, e); }
  GSYNC();
  phase3(p);
  GSYNC();
  { Epi2<2> e{p}; gemm_phase<2>((const bf16_t*)(p.ws + WS_ABUF), (const bf16_t*)(p.ws + WS_WT2), 8, smem, e); }
  GSYNC();
  ln_phase<0>(p);
  GSYNC();
  { Epi3<4> e{p}; gemm_phase<4>((const bf16_t*)(p.ws + WS_ABUF), (const bf16_t*)(p.ws + WS_WT3), 33, smem, e); }
  GSYNC();
  gdn_chunk_local(p, smem);
  GSYNC();
  gdn_scan(p, smem);
  GSYNC();
  phase9(p, smem);
  GSYNC();
  { Epi4<2> e{p}; gemm_phase<2>((const bf16_t*)(p.ws + WS_ABUF), (const bf16_t*)(p.ws + WS_WT4), 8, smem, e); }
  GSYNC();
  ln_phase<1>(p);
}

extern "C" void kernel_launch(void* const* d_in, const int* in_sizes, int n_in, void* d_out, int out_size, void* d_ws, size_t ws_size, hipStream_t stream) {
  static int grid_blocks = 0;
  if (!grid_blocks) {
    int dev = 0, cus = 0, per_cu = 0;
    hipGetDevice(&dev);
    hipDeviceGetAttribute(&cus, hipDeviceAttributeMultiprocessorCount, dev);
    hipFuncSetAttribute((const void*)fwd_megakernel, hipFuncAttributeMaxDynamicSharedMemorySize, LDS_BYTES);
    hipOccupancyMaxActiveBlocksPerMultiprocessor(&per_cu, (const void*)fwd_megakernel, 256, LDS_BYTES);
    if (per_cu < 1) per_cu = 1;
    if (per_cu > 2) per_cu = 2;
    grid_blocks = cus * per_cu;
    if (ws_size < 247 * MiB) fprintf(stderr, "kernel_launch: workspace too small: %zu\n", ws_size);
  }
  Params p{};
  const float** pp = (const float**)&p;
  for (int i = 0; i < 20; ++i) pp[i] = (const float*)d_in[i];
  p.out = (float*)d_out; p.ws = (char*)d_ws;
  hipMemsetAsync((char*)d_ws + WS_BAR, 0, XCD_BAR_WORDS * 4, stream);
  void* args[] = {&p};
  hipError_t e = hipLaunchCooperativeKernel((const void*)fwd_megakernel, dim3(grid_blocks), dim3(256), args, LDS_BYTES, stream);
  if (e != hipSuccess) fprintf(stderr, "cooperative launch failed: %s (grid %d)\n", hipGetErrorString(e), grid_blocks);
}
```

```cpp
#include <hip/hip_runtime.h>
#include <hip/hip_cooperative_groups.h>
#include <cstdio>
namespace cg = cooperative_groups;

typedef unsigned short bf16_t;
typedef short bf16x8 __attribute__((ext_vector_type(8)));
typedef float f32x16 __attribute__((ext_vector_type(16)));
typedef float f32x4 __attribute__((ext_vector_type(4)));
typedef unsigned u32x4 __attribute__((ext_vector_type(4)));
typedef unsigned u32x2 __attribute__((ext_vector_type(2)));

#define DI __device__ __forceinline__
#define MFMA32(a, b, c) __builtin_amdgcn_mfma_f32_32x32x16_bf16((a), (b), (c), 0, 0, 0)

constexpr int MTOT = 17408, MP = 16384;
constexpr size_t MiB = 1ull << 20;
constexpr size_t WS_WT1 = 0, WS_WT2 = 8 * MiB, WS_WT3 = 10 * MiB, WS_WT4 = 19 * MiB, WS_MOD = 21 * MiB, WS_STATS = 25 * MiB,
                 WS_BA = 25 * MiB + 512 * 1024, WS_GL = 26 * MiB + 768 * 1024, WS_BAR = 26 * MiB + 832 * 1024, WS_CST = 24 * MiB + 256 * 1024, WS_ABUF = 27 * MiB, WS_CH = 61 * MiB, WS_G1 = 95 * MiB,
                 WS_QKV = 129 * MiB, WS_ATTN = 231 * MiB;
constexpr size_t WS_U = WS_ABUF, WS_Z = WS_CH, WS_W = WS_G1, WS_O = WS_QKV;
constexpr size_t OUT_Y = 0, OUT_CAP = 17825792, OUT_CBP = 17842176, OUT_SSP = 17915904, OUT_CAS = 18964480, OUT_CBS = 19226624, OUT_SSS = 20406272;
constexpr int LDS_BYTES = 72192;
constexpr float ALPHA_F = 1.41421356237309515f;

struct Params {
  const float *x_p, *x_s, *st_conv_a, *st_conv_b, *st_ssm, *c_p, *c_s, *w_mod, *b_mod, *ln_g, *ln_b, *wa_in, *wa_conv, *wa_out, *wb_in, *wb_conv,
      *wb_a_log, *wb_dt_bias, *wb_norm, *wb_out;
  float* out;
  char* ws;
};

typedef float f32x2v __attribute__((ext_vector_type(2)));
typedef __bf16 bf16x2v __attribute__((ext_vector_type(2)));
DI unsigned pk2(float lo, float hi) { f32x2v v = {lo, hi}; bf16x2v b = __builtin_convertvector(v, bf16x2v); return __builtin_bit_cast(unsigned, b); }
DI unsigned f2bf(float x) { __bf16 b = (__bf16)x; return (unsigned)__builtin_bit_cast(unsigned short, b); }
DI float bflo(unsigned u) { return __uint_as_float(u << 16); }
DI float bfhi(unsigned u) { return __uint_as_float(u & 0xffff0000u); }
DI float bf2f(bf16_t v) { return __uint_as_float(((unsigned)v) << 16); }
DI float silu(float x) { return x * __builtin_amdgcn_rcpf(1.f + __expf(-x)); }
DI int otid() { int t = threadIdx.x; asm volatile("" : "+v"(t)); return t; }
DI int rowi(int i, int lane) { return (i & 3) + 8 * (i >> 2) + 4 * (lane >> 5); }
DI int bidx(int row) { return row < MP ? (row >> 11) : 8 + ((row - MP) >> 3); }
DI const float* xrow(const Params& p, int row) { return row < MP ? p.x_p + (size_t)row * 1024 : p.x_s + (size_t)(row - MP) * 1024; }
DI bf16x8 pack8(const f32x16& x, int s) {
  u32x4 r;
  r[0] = pk2(x[8 * s + 0], x[8 * s + 1]); r[1] = pk2(x[8 * s + 2], x[8 * s + 3]); r[2] = pk2(x[8 * s + 4], x[8 * s + 5]); r[3] = pk2(x[8 * s + 6], x[8 * s + 7]);
  return __builtin_bit_cast(bf16x8, r);
}


#define XB_TMO      128
#define XB_XCNT(j)  (256  + 64 * (j))
#define XB_XSUB(j)  (1280 + 64 * (j))
#define XB_XGEN(j)  (2304 + 64 * (j))
#define XB_TOP      3328
#define XB_TOPGEN   3392
#define XCD_BAR_WORDS 3456
#define XB_SPIN_CAP (1u << 18)
#define LAS __attribute__((address_space(3)))
DI unsigned xb_ld(unsigned* p) { return __hip_atomic_load(p, __ATOMIC_RELAXED, __HIP_MEMORY_SCOPE_AGENT); }
DI unsigned xb_add(unsigned* p, unsigned v) { return __hip_atomic_fetch_add(p, v, __ATOMIC_RELAXED, __HIP_MEMORY_SCOPE_AGENT); }
DI unsigned xb_xcc_id() { return (unsigned)__builtin_amdgcn_s_getreg((3 << 11) | 20) & 0xFu; }
#define XB_SPIN(cond, bar) do { unsigned _sp = 0; while (cond) { __builtin_amdgcn_s_sleep(1); \
    if ((++_sp & 255u) == 0u) { if (xb_ld(&(bar)[XB_TMO])) break; if (_sp > XB_SPIN_CAP) { atomicAdd(&(bar)[XB_TMO], 1u); break; } } } } while (0)
struct XcdBarrier { unsigned* bar; unsigned x; volatile LAS unsigned* st; };
DI XcdBarrier xcd_barrier_post(unsigned* bar, volatile LAS unsigned* st) {
  XcdBarrier b; b.bar = bar; b.x = xb_xcc_id(); b.st = st;
  if (threadIdx.x == 0) (void)xb_add(&bar[XB_XCNT(b.x)], 1u);
  return b;
}
DI void xcd_barrier_complete(unsigned* bar, unsigned x, unsigned& nloc, unsigned& nx) {
  const unsigned G = gridDim.x * gridDim.y * gridDim.z;
  unsigned sum, cnt, mine, sp = 0u;
  for (;;) {
    sum = 0u; cnt = 0u; mine = 0u;
#pragma unroll
    for (unsigned j = 0; j < 16; ++j) { const unsigned c = xb_ld(&bar[XB_XCNT(j)]); sum += c; cnt += (c > 0u) ? 1u : 0u; mine = (j == x) ? c : mine; }
    if (sum == G) break;
    __builtin_amdgcn_s_sleep(1);
    if ((++sp & 255u) == 0u) { if (xb_ld(&bar[XB_TMO])) break; if (sp > XB_SPIN_CAP) { atomicAdd(&bar[XB_TMO], 1u); break; } }
  }
  nloc = mine > 0u ? mine : 1u; nx = cnt > 0u ? cnt : 1u;
}
DI void xcd_barrier(const XcdBarrier& b) {
  asm volatile("s_waitcnt vmcnt(0)" ::: "memory");
  __syncthreads();
  if (threadIdx.x == 0) {
    unsigned* bar = b.bar;
    __builtin_amdgcn_s_waitcnt(0);
    unsigned nloc = b.st[0], nx = b.st[1];
    if (nloc == 0u) { xcd_barrier_complete(bar, b.x, nloc, nx); b.st[0] = nloc; b.st[1] = nx; }
    const unsigned old = xb_add(&bar[XB_XSUB(b.x)], 1u);
    const unsigned gen = old / nloc;
    if (old + 1u == (gen + 1u) * nloc) {
      __builtin_amdgcn_fence(__ATOMIC_RELEASE, "agent");
      asm volatile("s_waitcnt vmcnt(0)" ::: "memory");
      const unsigned og = xb_add(&bar[XB_TOP], 1u);
      const unsigned tg = og / nx;
      if (og + 1u == (tg + 1u) * nx) xb_add(&bar[XB_TOPGEN], 1u);
      else XB_SPIN(xb_ld(&bar[XB_TOPGEN]) == tg, bar);
      __builtin_amdgcn_fence(__ATOMIC_ACQUIRE, "agent");
      xb_add(&bar[XB_XGEN(b.x)], 1u);
      asm volatile("s_waitcnt vmcnt(0)" ::: "memory");
    } else {
      XB_SPIN(xb_ld(&bar[XB_XGEN(b.x)]) == gen, bar);
      __builtin_amdgcn_fence(__ATOMIC_ACQUIRE, "agent");
      asm volatile("s_waitcnt vmcnt(0)" ::: "memory");
    }
  }
  __syncthreads();
}
DI void lds_barrier() { asm volatile("s_waitcnt lgkmcnt(0)\n\ts_barrier" ::: "memory"); }

DI void phase0a(const Params& p) {
  float* CST = (float*)(p.ws + WS_CST);
  for (int idx = blockIdx.x * 256 + otid(); idx < 1024 * 160; idx += gridDim.x * 256) {
    const int k = idx / 160, r = idx - k * 160;
    float v = 0.f;
    if (r < 8) v = silu(p.c_p[r * 1024 + k]); else if (r < 136) v = silu(p.c_s[(r - 8) * 1024 + k]);
    CST[idx] = v;
  }
}
DI void phase0(const Params& p, char* smem) {
  float* MOD = (float*)(p.ws + WS_MOD);
  const float* CST = (const float*)(p.ws + WS_CST);
  const int nmod = gridDim.x >= 384 ? 192 : 0;
  const int tstep = gridDim.x - nmod;
  if (nmod == 0 || (int)blockIdx.x < nmod)
  for (int task = blockIdx.x; task < 192; task += gridDim.x) {
    int tid = threadIdx.x; asm volatile("" : "+v"(tid));
    {
      const int l = task / 96, cb = task % 96;
      const int lane = tid & 63, wave = tid >> 6;
      float* red = (float*)smem;
      __syncthreads();
      for (int i = tid; i < 160 * 32; i += 256) red[i] = 0.f;
      __syncthreads();
      f32x16 acc[5];
#pragma unroll
      for (int mt = 0; mt < 5; ++mt)
#pragma unroll
        for (int i = 0; i < 16; ++i) acc[mt][i] = 0.f;
      const float* wm = p.w_mod + (size_t)l * 1024 * 3072 + cb * 32 + (lane & 31) + (size_t)(wave * 256 + (lane >> 5)) * 3072;
      const float* ct = CST + (lane & 31) + (wave * 256 + (lane >> 5)) * 160;
      float bA[8], aA[8][5], bB[8], aB[8][5];
#define MOD_LOAD(bb, aa, g) { _Pragma("unroll") for (int u = 0; u < 8; ++u) { const int kk = 2 * ((g) * 8 + u); bb[u] = wm[(size_t)kk * 3072]; _Pragma("unroll") for (int mt = 0; mt < 5; ++mt) aa[u][mt] = ct[kk * 160 + mt * 32]; } }
#define MOD_COMP(bb, aa) { _Pragma("unroll") for (int u = 0; u < 8; ++u) { _Pragma("unroll") for (int mt = 0; mt < 5; ++mt) acc[mt] = __builtin_amdgcn_mfma_f32_32x32x2f32(aa[u][mt], bb[u], acc[mt], 0, 0, 0); } }
      MOD_LOAD(bA, aA, 0);
#pragma unroll 1
      for (int g = 0; g < 16; g += 2) {
        MOD_LOAD(bB, aB, g + 1);
        MOD_COMP(bA, aA);
        { const int g2 = g + 2 < 16 ? g + 2 : 15; MOD_LOAD(bA, aA, g2); }
        MOD_COMP(bB, aB);
      }
#pragma unroll
      for (int mt = 0; mt < 5; ++mt)
#pragma unroll
        for (int i = 0; i < 16; ++i) atomicAdd(&red[(mt * 32 + rowi(i, lane)) * 32 + (lane & 31)], acc[mt][i]);
      __syncthreads();
      {
        const int col = tid & 31;
        const float bm = p.b_mod[l * 3072 + cb * 32 + col];
        for (int r = tid >> 5; r < 136; r += 8) MOD[((size_t)l * 136 + r) * 3072 + cb * 32 + col] = red[r * 32 + col] + bm;
      }
    }
  }
  if ((int)blockIdx.x >= nmod) {
    {
      const int tid = threadIdx.x;
      const int TOT = (4096 + 1024 + 4224 + 1024) * 128;
      const int nthr = tstep * 256;
      for (int it0 = ((int)blockIdx.x - nmod) * 256 + tid; it0 < TOT; it0 += 2 * nthr) {
        float v[2][8]; bf16_t* dptr[2]; bool ok[2];
#pragma unroll
        for (int u = 0; u < 2; ++u) {
          int it = it0 + u * nthr; ok[u] = it < TOT; if (!ok[u]) it = it0;
          const float* src; int ldw, N, mode; bf16_t* dst;
          if (it < 4096 * 128) { src = p.wa_in; ldw = 4096; N = 4096; mode = 1; dst = (bf16_t*)(p.ws + WS_WT1); }
          else if (it < 5120 * 128) { it -= 4096 * 128; src = p.wa_out; ldw = 1024; N = 1024; mode = 0; dst = (bf16_t*)(p.ws + WS_WT2); }
          else if (it < 9344 * 128) { it -= 5120 * 128; src = p.wb_in; ldw = 4112; N = 4224; mode = 2; dst = (bf16_t*)(p.ws + WS_WT3); }
          else { it -= 9344 * 128; src = p.wb_out; ldw = 1024; N = 1024; mode = 0; dst = (bf16_t*)(p.ws + WS_WT4); }
          const int k8 = it / N, np = it - k8 * N;
          int sc = np;
          if (mode == 1) { const int nt128 = np >> 7, seg = (np >> 5) & 3, j = np & 31; sc = (seg == 0 ? 1024 : seg == 1 ? 2048 : seg == 2 ? 0 : 3072) + nt128 * 32 + j; }
          const bool valid = !(mode == 2 && np >= 4112);
          const float* sp = src + (size_t)(k8 * 8) * ldw + (valid ? sc : 0);
#pragma unroll
          for (int j = 0; j < 8; ++j) { const float x = sp[(size_t)j * ldw]; v[u][j] = valid ? x : 0.f; }
          dptr[u] = dst + ((size_t)((np >> 5) * 64 + (k8 >> 1)) * 64 + (np & 31) + 32 * (k8 & 1)) * 8;
        }
#pragma unroll
        for (int u = 0; u < 2; ++u) if (ok[u]) {
          u32x4 o; o[0] = pk2(v[u][0], v[u][1]); o[1] = pk2(v[u][2], v[u][3]); o[2] = pk2(v[u][4], v[u][5]); o[3] = pk2(v[u][6], v[u][7]);
          *(u32x4*)dptr[u] = o;
        }
      }
    }
  }
}

DI void phase1(const Params& p) {
  const float* MOD = (const float*)(p.ws + WS_MOD);
  bf16_t* AB = (bf16_t*)(p.ws + WS_ABUF);
  for (int i = blockIdx.x * 256 + otid(); i < MTOT * 128; i += gridDim.x * 256) {
    const int row = i >> 7, c8 = (i & 127) * 8;
    const float* xr = xrow(p, row) + c8;
    const float* md = MOD + (size_t)bidx(row) * 3072 + c8;
    const f32x4 x0 = *(const f32x4*)xr, x1 = *(const f32x4*)(xr + 4);
    const f32x4 sh0 = *(const f32x4*)md, sh1 = *(const f32x4*)(md + 4), sc0 = *(const f32x4*)(md + 1024), sc1 = *(const f32x4*)(md + 1028);
    u32x4 o;
    o[0] = pk2(x0[0] * (1.f + sc0[0]) + sh0[0], x0[1] * (1.f + sc0[1]) + sh0[1]);
    o[1] = pk2(x0[2] * (1.f + sc0[2]) + sh0[2], x0[3] * (1.f + sc0[3]) + sh0[3]);
    o[2] = pk2(x1[0] * (1.f + sc1[0]) + sh1[0], x1[1] * (1.f + sc1[1]) + sh1[1]);
    o[3] = pk2(x1[2] * (1.f + sc1[2]) + sh1[2], x1[3] * (1.f + sc1[3]) + sh1[3]);
    *(u32x4*)(AB + (size_t)row * 1024 + c8) = o;
  }
}

template <int MI, class Epi>
DI void gemm_phase(const bf16_t* __restrict__ A, const bf16_t* __restrict__ Bt, const int ntN, char* smem, const Epi& epi) {
  constexpr int BM = 64 * MI;
  bf16_t* sA = (bf16_t*)smem;
  const int ntiles = (MTOT / BM) * ntN;
  for (int t = blockIdx.x; t < ntiles; t += gridDim.x) {
    const int tid = otid(), lane = tid & 63, wave = tid >> 6, wr = wave >> 1, wc = wave & 1;
    const int lrow = tid >> 3, lkc = (tid & 7) * 8;
    const int mt = t / ntN, nt = t - mt * ntN;
    const bf16_t* Ag = A + ((size_t)mt * BM + lrow) * 1024 + lkc;
    const bf16_t* Bf = Bt + (size_t)(nt * 4 + wc * 2) * 64 * 512 + lane * 8;
    f32x16 acc[MI][2];
#pragma unroll
    for (int mi = 0; mi < MI; ++mi)
#pragma unroll
      for (int nj = 0; nj < 2; ++nj)
#pragma unroll
        for (int i = 0; i < 16; ++i) acc[mi][nj][i] = 0.f;
    typename Epi::Pre pre;
    epi.prefetch(mt * BM + wr * (32 * MI), nt, wc, lane, pre);
    u32x4 ra[2 * MI];
    bf16x8 bfr[2][4];
#pragma unroll
    for (int q = 0; q < 2 * MI; ++q) ra[q] = *(const u32x4*)(Ag + (size_t)q * 32 * 1024);
#pragma unroll
    for (int nj = 0; nj < 2; ++nj)
#pragma unroll
      for (int ks = 0; ks < 4; ++ks) bfr[nj][ks] = *(const bf16x8*)(Bf + (size_t)(nj * 64 + ks) * 512);
    for (int kt = 0; kt < 16; ++kt) {
      lds_barrier();
#pragma unroll
      for (int q = 0; q < 2 * MI; ++q) *(u32x4*)(sA + (lrow + 32 * q) * 72 + lkc) = ra[q];
      lds_barrier();
      const int kn = kt < 15 ? kt + 1 : 15;
#pragma unroll
      for (int q = 0; q < 2 * MI; ++q) ra[q] = *(const u32x4*)(Ag + (size_t)q * 32 * 1024 + kn * 64);
      __builtin_amdgcn_sched_barrier(0);
      __builtin_amdgcn_s_setprio(2);
#pragma unroll
      for (int ks = 0; ks < 4; ++ks) {
        bf16x8 a[MI];
#pragma unroll
        for (int mi = 0; mi < MI; ++mi) a[mi] = *(const bf16x8*)(sA + (wr * (32 * MI) + mi * 32 + (lane & 31)) * 72 + ks * 16 + (lane >> 5) * 8);
#pragma unroll
        for (int mi = 0; mi < MI; ++mi)
#pragma unroll
          for (int nj = 0; nj < 2; ++nj) acc[mi][nj] = MFMA32(a[mi], bfr[nj][ks], acc[mi][nj]);
#pragma unroll
        for (int nj = 0; nj < 2; ++nj) bfr[nj][ks] = *(const bf16x8*)(Bf + (size_t)(nj * 64 + kn * 4 + ks) * 512);
      }
      __builtin_amdgcn_s_setprio(0);
    }
    epi(mt * BM + wr * (32 * MI), nt, wc, lane, acc, pre);
  }
}

DI unsigned pair_pk(float v0, float v1, int lane) {
  const bool odd = lane & 1;
  const float send = odd ? v0 : v1;
  const float recv = __builtin_bit_cast(float, __builtin_amdgcn_update_dpp(0, __builtin_bit_cast(int, send), 0xB1, 0xF, 0xF, true));
  return odd ? pk2(recv, v1) : pk2(v0, recv);
}
template <int MI> struct Epi1 {
  struct Pre {};
  DI void prefetch(int, int, int, int, Pre&) const {}
  bf16_t* CH; bf16_t* G1; float* out;
  template <bool TAIL> DI void body(int row0, int nt, int wc, int lane, const f32x16 (&acc)[MI][2]) const {
    const int ch = nt * 32 + (lane & 31);
    bf16_t* dst = (wc == 0 ? CH : G1) + (ch & ~1);
#pragma unroll
    for (int mi = 0; mi < MI; ++mi)
#pragma unroll
      for (int ip = 0; ip < 8; ++ip) {
        float v[2];
#pragma unroll
        for (int u = 0; u < 2; ++u) {
          const int i = 2 * ip + u;
          v[u] = wc == 0 ? acc[mi][0][i] * acc[mi][1][i] : acc[mi][0][i] * silu(acc[mi][1][i]);
          if (TAIL && wc == 0) {
            const int row = row0 + mi * 32 + rowi(i, lane);
            if (row < MP) { const int t = row & 2047; if (t >= 2046) out[OUT_CAP + (size_t)((row >> 11) * 2 + (t - 2046)) * 1024 + ch] = v[u]; }
            else { const int t = row & 7; if (t >= 6) out[OUT_CAS + (size_t)(((row - MP) >> 3) * 2 + (t - 6)) * 1024 + ch] = v[u]; }
          }
        }
        const int row = row0 + mi * 32 + rowi(2 * ip + (lane & 1), lane);
        *(unsigned*)(dst + (size_t)row * 1024) = pair_pk(v[0], v[1], lane);
      }
  }
  DI void operator()(int row0, int nt, int wc, int lane, const f32x16 (&acc)[MI][2], const Pre& pre) const {
    const bool tail = row0 >= MP || ((row0 + 32 * MI - 1) & 2047) >= 2046;
    if (tail) body<true>(row0, nt, wc, lane, acc); else body<false>(row0, nt, wc, lane, acc);
  }
};
template <int MI> struct Epi2 {
  Params p;
  struct Pre { float v[MI][2][16]; };
  DI void prefetch(int row0, int nt, int wc, int lane, Pre& pre) const {
    const float* base = xrow(p, row0 + 4 * (lane >> 5)) + nt * 128 + wc * 64 + (lane & 31);
#pragma unroll
    for (int mi = 0; mi < MI; ++mi)
#pragma unroll
      for (int i = 0; i < 16; ++i)
#pragma unroll
        for (int nj = 0; nj < 2; ++nj) pre.v[mi][nj][i] = __builtin_nontemporal_load(base + (mi * 32 + (i & 3) + 8 * (i >> 2)) * 1024 + nj * 32);
  }
  template <bool PROMPT> DI void body(int row0, int nt, int wc, int lane, const f32x16 (&acc)[MI][2], const Pre& pre) const {
    const float* MOD = (const float*)(p.ws + WS_MOD);
    const int c0 = nt * 128 + wc * 64 + (lane & 31);
    float g0 = 0.f, g1 = 0.f;
    if (PROMPT) { const float* gt = MOD + (size_t)(row0 >> 11) * 3072 + 2048 + c0; g0 = gt[0]; g1 = gt[32]; }
#pragma unroll
    for (int mi = 0; mi < MI; ++mi)
#pragma unroll
      for (int i = 0; i < 16; ++i) {
        const int row = row0 + mi * 32 + rowi(i, lane);
        if (!PROMPT) { const float* gt = MOD + (size_t)bidx(row) * 3072 + 2048 + c0; g0 = gt[0]; g1 = gt[32]; }
        float* yp = p.out + OUT_Y + (size_t)row * 1024 + c0;
        yp[0] = ALPHA_F * pre.v[mi][0][i] + g0 * acc[mi][0][i];
        yp[32] = ALPHA_F * pre.v[mi][1][i] + g1 * acc[mi][1][i];
      }
  }
  DI void operator()(int row0, int nt, int wc, int lane, const f32x16 (&acc)[MI][2], const Pre& pre) const {
    if (row0 < MP) body<true>(row0, nt, wc, lane, acc, pre); else body<false>(row0, nt, wc, lane, acc, pre);
  }
};
template <int MI> struct Epi3 {
  Params p;
  struct Pre {};
  DI void prefetch(int, int, int, int, Pre&) const {}
  template <bool TAIL> DI void body(int row0, int nt, int wc, int lane, const f32x16 (&acc)[MI][2]) const {
    bf16_t* QKV = (bf16_t*)(p.ws + WS_QKV); bf16_t* Z = (bf16_t*)(p.ws + WS_Z); float* BA = (float*)(p.ws + WS_BA);
    if (nt < 32) {
#pragma unroll
      for (int nj = 0; nj < 2; ++nj) {
        const int col = nt * 128 + wc * 64 + nj * 32 + (lane & 31);
        bf16_t* dst = nt < 24 ? QKV + (col & ~1) : Z + ((col - 3072) & ~1);
        const int ld = nt < 24 ? 3072 : 1024;
#pragma unroll
        for (int mi = 0; mi < MI; ++mi)
#pragma unroll
          for (int ip = 0; ip < 8; ++ip) {
            if (TAIL && nt < 24) {
#pragma unroll
              for (int u = 0; u < 2; ++u) {
                const int row = row0 + mi * 32 + rowi(2 * ip + u, lane);
                const float v = acc[mi][nj][2 * ip + u];
                if (row < MP) { const int t = row & 2047; if (t >= 2045) p.out[OUT_CBP + (size_t)((row >> 11) * 3 + (t - 2045)) * 3072 + col] = v; }
                else { const int t = row & 7; if (t >= 5) p.out[OUT_CBS + (size_t)(((row - MP) >> 3) * 3 + (t - 5)) * 3072 + col] = v; }
              }
            }
            const int row = row0 + mi * 32 + rowi(2 * ip + (lane & 1), lane);
            *(unsigned*)(dst + (size_t)row * ld) = pair_pk(acc[mi][nj][2 * ip], acc[mi][nj][2 * ip + 1], lane);
          }
      }
    } else if (wc == 0 && (lane & 31) < 16) {
#pragma unroll
      for (int mi = 0; mi < MI; ++mi)
#pragma unroll
        for (int i = 0; i < 16; ++i) BA[(size_t)(row0 + mi * 32 + rowi(i, lane)) * 16 + (lane & 31)] = acc[mi][0][i];
    }
  }
  DI void operator()(int row0, int nt, int wc, int lane, const f32x16 (&acc)[MI][2], const Pre& pre) const {
    const bool tail = row0 >= MP || ((row0 + 32 * MI - 1) & 2047) >= 2045;
    if (tail) body<true>(row0, nt, wc, lane, acc); else body<false>(row0, nt, wc, lane, acc);
  }
};
template <int MI> struct Epi4 {
  Params p;
  struct Pre { float v[MI][2][16]; };
  DI void prefetch(int row0, int nt, int wc, int lane, Pre& pre) const {
    const float* base = p.out + OUT_Y + (size_t)(row0 + 4 * (lane >> 5)) * 1024 + nt * 128 + wc * 64 + (lane & 31);
#pragma unroll
    for (int mi = 0; mi < MI; ++mi)
#pragma unroll
      for (int i = 0; i < 16; ++i)
#pragma unroll
        for (int nj = 0; nj < 2; ++nj) pre.v[mi][nj][i] = __builtin_nontemporal_load(base + (mi * 32 + (i & 3) + 8 * (i >> 2)) * 1024 + nj * 32);
  }
  template <bool PROMPT> DI void body(int row0, int nt, int wc, int lane, const f32x16 (&acc)[MI][2], const Pre& pre) const {
    const float* MOD = (const float*)(p.ws + WS_MOD) + (size_t)136 * 3072;
    const float* ST = (const float*)(p.ws + WS_STATS);
    const int c0 = nt * 128 + wc * 64 + (lane & 31);
    const float lg0 = p.ln_g[c0], lg1 = p.ln_g[c0 + 32], lb0 = p.ln_b[c0], lb1 = p.ln_b[c0 + 32];
    float g0 = 0.f, g1 = 0.f;
    if (PROMPT) { const float* gt = MOD + (size_t)(row0 >> 11) * 3072 + 2048 + c0; g0 = gt[0]; g1 = gt[32]; }
#pragma unroll
    for (int mi = 0; mi < MI; ++mi)
#pragma unroll
      for (int i = 0; i < 16; ++i) {
        const int row = row0 + mi * 32 + rowi(i, lane);
        const float mu = ST[row * 2], rstd = ST[row * 2 + 1];
        if (!PROMPT) { const float* gt = MOD + (size_t)bidx(row) * 3072 + 2048 + c0; g0 = gt[0]; g1 = gt[32]; }
        float* yp = p.out + OUT_Y + (size_t)row * 1024 + c0;
        yp[0] = ALPHA_F * ((pre.v[mi][0][i] - mu) * rstd * lg0 + lb0) + g0 * acc[mi][0][i];
        yp[32] = ALPHA_F * ((pre.v[mi][1][i] - mu) * rstd * lg1 + lb1) + g1 * acc[mi][1][i];
      }
  }
  DI void operator()(int row0, int nt, int wc, int lane, const f32x16 (&acc)[MI][2], const Pre& pre) const {
    if (row0 < MP) body<true>(row0, nt, wc, lane, acc, pre); else body<false>(row0, nt, wc, lane, acc, pre);
  }
};

DI void phase3(const Params& p) {
  const bf16_t* CH = (const bf16_t*)(p.ws + WS_CH); const bf16_t* G1 = (const bf16_t*)(p.ws + WS_G1);
  bf16_t* AB = (bf16_t*)(p.ws + WS_ABUF);
  for (int i = blockIdx.x * 256 + otid(); i < MTOT * 128; i += gridDim.x * 256) {
    const int row = i >> 7, c8 = (i & 127) * 8;
    const bool smp = row >= MP;
    const int t = smp ? (row & 7) : (row & 2047);
    float cur[8], p1[8], p2[8], g[8];
    { const u32x4 r = *(const u32x4*)(CH + (size_t)row * 1024 + c8);
#pragma unroll
      for (int e = 0; e < 4; ++e) { cur[2 * e] = bflo(r[e]); cur[2 * e + 1] = bfhi(r[e]); } }
    { const u32x4 r = __builtin_nontemporal_load((const u32x4*)(G1 + (size_t)row * 1024 + c8));
#pragma unroll
      for (int e = 0; e < 4; ++e) { g[2 * e] = bflo(r[e]); g[2 * e + 1] = bfhi(r[e]); } }
    if (t >= 1) { const u32x4 r = *(const u32x4*)(CH + (size_t)(row - 1) * 1024 + c8);
#pragma unroll
      for (int e = 0; e < 4; ++e) { p1[2 * e] = bflo(r[e]); p1[2 * e + 1] = bfhi(r[e]); } }
    else if (smp) { const float* b = p.st_conv_a + ((size_t)((row - MP) >> 3) * 2 + 1) * 1024 + c8;
#pragma unroll
      for (int e = 0; e < 8; ++e) p1[e] = b[e]; }
    else {
#pragma unroll
      for (int e = 0; e < 8; ++e) p1[e] = 0.f; }
    if (t >= 2) { const u32x4 r = *(const u32x4*)(CH + (size_t)(row - 2) * 1024 + c8);
#pragma unroll
      for (int e = 0; e < 4; ++e) { p2[2 * e] = bflo(r[e]); p2[2 * e + 1] = bfhi(r[e]); } }
    else if (smp) { const float* b = p.st_conv_a + ((size_t)((row - MP) >> 3) * 2 + t) * 1024 + c8;
#pragma unroll
      for (int e = 0; e < 8; ++e) p2[e] = b[e]; }
    else {
#pragma unroll
      for (int e = 0; e < 8; ++e) p2[e] = 0.f; }
    float o[8];
#pragma unroll
    for (int e = 0; e < 8; ++e) o[e] = g[e] * (p.wa_conv[c8 + e] * p2[e] + p.wa_conv[1024 + c8 + e] * p1[e] + p.wa_conv[2048 + c8 + e] * cur[e]);
    u32x4 ov; ov[0] = pk2(o[0], o[1]); ov[1] = pk2(o[2], o[3]); ov[2] = pk2(o[4], o[5]); ov[3] = pk2(o[6], o[7]);
    *(u32x4*)(AB + (size_t)row * 1024 + c8) = ov;
  }
}

template <int FINAL>
DI void ln_phase(const Params& p) {
  const int tid0 = otid();
  const int lane = tid0 & 63;
  const int gw = blockIdx.x * 4 + (tid0 >> 6), nw = gridDim.x * 4;
  const float* MOD1 = (const float*)(p.ws + WS_MOD) + (size_t)136 * 3072;
  float* ST = (float*)(p.ws + WS_STATS);
  bf16_t* AB = (bf16_t*)(p.ws + WS_ABUF);
  const float* lg = p.ln_g + (FINAL ? 1024 : 0); const float* lb = p.ln_b + (FINAL ? 1024 : 0);
  for (int row = gw; row < MTOT; row += nw) {
    float* yr = p.out + OUT_Y + (size_t)row * 1024;
    f32x4 v[4];
    float s = 0.f;
#pragma unroll
    for (int j = 0; j < 4; ++j) { v[j] = FINAL ? __builtin_nontemporal_load((const f32x4*)(yr + j * 256 + lane * 4)) : *(const f32x4*)(yr + j * 256 + lane * 4); s += v[j][0] + v[j][1] + v[j][2] + v[j][3]; }
#pragma unroll
    for (int o = 32; o >= 1; o >>= 1) s += __shfl_xor(s, o);
    const float mu = s * (1.f / 1024.f);
    float q = 0.f;
#pragma unroll
    for (int j = 0; j < 4; ++j)
#pragma unroll
      for (int e = 0; e < 4; ++e) { const float d = v[j][e] - mu; q += d * d; }
#pragma unroll
    for (int o = 32; o >= 1; o >>= 1) q += __shfl_xor(q, o);
    const float rstd = rsqrtf(q * (1.f / 1024.f) + 1e-5f);
    if (!FINAL && lane == 0) { ST[row * 2] = mu; ST[row * 2 + 1] = rstd; }
    const float* md = MOD1 + (size_t)bidx(row) * 3072;
#pragma unroll
    for (int j = 0; j < 4; ++j) {
      const int col = j * 256 + lane * 4;
      const f32x4 g4 = *(const f32x4*)(lg + col), b4 = *(const f32x4*)(lb + col);
      f32x4 x1;
#pragma unroll
      for (int e = 0; e < 4; ++e) x1[e] = (v[j][e] - mu) * rstd * g4[e] + b4[e];
      if (FINAL) { __builtin_nontemporal_store(x1, (f32x4*)(yr + col)); }
      else {
        const f32x4 sh = *(const f32x4*)(md + col), sc = *(const f32x4*)(md + 1024 + col);
        u32x2 o; o[0] = pk2(x1[0] * (1.f + sc[0]) + sh[0], x1[1] * (1.f + sc[1]) + sh[1]); o[1] = pk2(x1[2] * (1.f + sc[2]) + sh[2], x1[3] * (1.f + sc[3]) + sh[3]);
        *(u32x2*)(AB + (size_t)row * 1024 + col) = o;
      }
    }
  }
}

DI void gdn_chunk_local(const Params& p, char* smem0) {
  for (int task = blockIdx.x; task < 2048; task += gridDim.x) {
  int tid = threadIdx.x; asm volatile("" : "+v"(tid));
  int off0 = 0; asm volatile("" : "+v"(off0));
  char* smem = (char*)__builtin_assume_aligned(smem0 + (off0 & ~15), 16);
  const int lane = tid & 63, wave = __builtin_amdgcn_readfirstlane(tid >> 6);
  bf16_t* sq = (bf16_t*)smem;
  bf16_t* sk = sq + 64 * 136;
  bf16_t* sv = sk + 64 * 136;
  float* sAm = (float*)(smem + 3 * 17408);
  float* sc = (float*)(smem + 4 * 17408);
  float *sG = sc, *sBeta = sc + 64, *sRq = sc + 128, *sRk = sc + 192, *sSsq = sc + 256, *sSsk = sc + 320, *sBk = sc + 384, *sEg = sc + 448, *sKt = sc + 512;
  const bf16_t* QKV = (const bf16_t*)(p.ws + WS_QKV);
  const float* BA = (const float*)(p.ws + WS_BA);
  float* GL = (float*)(p.ws + WS_GL);
  bf16_t* Ug = (bf16_t*)(p.ws + WS_U); bf16_t* Wg = (bf16_t*)(p.ws + WS_W); bf16_t* ATT = (bf16_t*)(p.ws + WS_ATTN);
  bf16_t* QG = (bf16_t*)(p.out + OUT_SSS); bf16_t* KT = QG + (size_t)2048 * 8192;
  {
    const int n = task & 31, h = (task >> 5) & 7, b = task >> 8;
    const int row0 = b * 2048 + n * 64;
    {
      const int cg16 = tid & 15, rsub = tid >> 4;
      u32x4 raw[3][7];
#pragma unroll
      for (int seg = 0; seg < 3; ++seg)
#pragma unroll
        for (int r7 = 0; r7 < 7; ++r7) {
          const int ii = rsub * 4 - 3 + r7;
          if (n * 64 + ii >= 0) raw[seg][r7] = *(const u32x4*)(QKV + (size_t)(row0 + ii) * 3072 + seg * 1024 + h * 128 + cg16 * 8);
          else { raw[seg][r7][0] = 0u; raw[seg][r7][1] = 0u; raw[seg][r7][2] = 0u; raw[seg][r7][3] = 0u; }
        }
#pragma unroll
      for (int seg = 0; seg < 3; ++seg) {
        const int colbase = seg * 1024 + h * 128 + cg16 * 8;
        float wt[4][8];
#pragma unroll
        for (int j = 0; j < 4; ++j) {
          const f32x4 w0 = *(const f32x4*)(p.wb_conv + j * 3072 + colbase), w1 = *(const f32x4*)(p.wb_conv + j * 3072 + colbase + 4);
#pragma unroll
          for (int e = 0; e < 4; ++e) { wt[j][e] = w0[e]; wt[j][4 + e] = w1[e]; }
        }
        bf16_t* dst = sq + seg * (64 * 136);
#pragma unroll
        for (int o4 = 0; o4 < 4; ++o4) {
          const int i = rsub * 4 + o4;
          float a8[8];
#pragma unroll
          for (int e = 0; e < 8; ++e) a8[e] = 0.f;
#pragma unroll
          for (int j = 0; j < 4; ++j) {
#pragma unroll
            for (int e = 0; e < 4; ++e) { a8[2 * e] += wt[j][2 * e] * bflo(raw[seg][o4 + j][e]); a8[2 * e + 1] += wt[j][2 * e + 1] * bfhi(raw[seg][o4 + j][e]); }
          }
          float ss = 0.f;
#pragma unroll
          for (int e = 0; e < 8; ++e) { a8[e] = silu(a8[e]); ss += a8[e] * a8[e]; }
          u32x4 o; o[0] = pk2(a8[0], a8[1]); o[1] = pk2(a8[2], a8[3]); o[2] = pk2(a8[4], a8[5]); o[3] = pk2(a8[6], a8[7]);
          *(u32x4*)(dst + i * 136 + cg16 * 8) = o;
          if (seg < 2) {
#pragma unroll
            for (int o2 = 8; o2 >= 1; o2 >>= 1) ss += __shfl_xor(ss, o2);
            if (cg16 == 0) sSsq[seg * 64 + i] = ss;
          }
        }
      }
    }
    __syncthreads();
    if (tid < 64) {
      const int row = row0 + tid;
      const float bb = BA[(size_t)row * 16 + h], aa = BA[(size_t)row * 16 + 8 + h];
      const float beta = 1.f / (1.f + expf(-bb));
      const float xx = aa + p.wb_dt_bias[h];
      const float sp = xx > 20.f ? xx : log1pf(expf(xx));
      const float g = -expf(p.wb_a_log[h]) * sp;
      float G = g;
#pragma unroll
      for (int off = 1; off < 64; off <<= 1) { const float tv = __shfl_up(G, off); if (lane >= off) G += tv; }
      const float Gl = __shfl(G, 63);
      const float rk = rsqrtf(sSsk[tid] + 1e-6f), rq = rsqrtf(sSsq[tid] + 1e-6f) * 0.08838834764831845f;
      const float eg = expf(G);
      sG[tid] = G; sBeta[tid] = beta; sRq[tid] = rq * eg; sRk[tid] = rk; sBk[tid] = rk * beta * eg; sEg[tid] = rq; sKt[tid] = rk * expf(Gl - G);
      if (tid == 63) GL[task] = eg;
    }
    __syncthreads();
    {
      bf16_t* qgo = QG + (size_t)task * 8192; bf16_t* kto = KT + (size_t)task * 8192;
#pragma unroll
      for (int c4 = 0; c4 < 4; ++c4) {
        const int o = tid + 256 * c4;
        {
          const int mt = o >> 9, s = (o >> 6) & 7, ln = o & 63, i = mt * 32 + (ln & 31), hh = ln >> 5;
          const u32x2 lo = *(const u32x2*)(sq + i * 136 + s * 16 + hh * 4), hi = *(const u32x2*)(sq + i * 136 + s * 16 + 8 + hh * 4);
          const float f = sRq[i];
          u32x4 ov; ov[0] = pk2(bflo(lo[0]) * f, bfhi(lo[0]) * f); ov[1] = pk2(bflo(lo[1]) * f, bfhi(lo[1]) * f);
          ov[2] = pk2(bflo(hi[0]) * f, bfhi(hi[0]) * f); ov[3] = pk2(bflo(hi[1]) * f, bfhi(hi[1]) * f);
          *(u32x4*)(qgo + (size_t)o * 8) = ov;
        }
        {
          const int mt = o >> 8, s = (o >> 6) & 3, ln = o & 63, m = mt * 32 + (ln & 31), hh = ln >> 5;
          float vv[8];
#pragma unroll
          for (int e = 0; e < 8; ++e) { const int j = s * 16 + (e >> 2) * 8 + hh * 4 + (e & 3); vv[e] = bf2f(sk[j * 136 + m]) * sKt[j]; }
          u32x4 ov; ov[0] = pk2(vv[0], vv[1]); ov[1] = pk2(vv[2], vv[3]); ov[2] = pk2(vv[4], vv[5]); ov[3] = pk2(vv[6], vv[7]);
          *(u32x4*)(kto + (size_t)o * 8) = ov;
        }
      }
    }
    const int mat = wave >> 1, gmi = wave & 1;
    f32x16 g2[2];
#pragma unroll
    for (int nj = 0; nj < 2; ++nj)
#pragma unroll
      for (int i = 0; i < 16; ++i) g2[nj][i] = 0.f;
    {
      const bf16_t* srcA = mat ? sq : sk;
#pragma unroll
      for (int ks = 0; ks < 8; ++ks) {
        const bf16x8 a = *(const bf16x8*)(srcA + (gmi * 32 + (lane & 31)) * 136 + ks * 16 + (lane >> 5) * 8);
#pragma unroll
        for (int nj = 0; nj < 2; ++nj) {
          const bf16x8 bb = *(const bf16x8*)(sk + (nj * 32 + (lane & 31)) * 136 + ks * 16 + (lane >> 5) * 8);
          g2[nj] = MFMA32(a, bb, g2[nj]);
        }
      }
    }
    __syncthreads();
#pragma unroll
    for (int nj = 0; nj < 2; ++nj)
#pragma unroll
      for (int r = 0; r < 16; ++r) {
        const int i = gmi * 32 + rowi(r, lane), j = nj * 32 + (lane & 31);
        const float dec = __expf(fminf(sG[i] - sG[j], 0.f));
        if (mat == 0) {
          sAm[i * 68 + j] = (i > j) ? sBeta[i] * sRk[i] * sRk[j] * dec * g2[nj][r] : 0.f;
        } else {
          const float val = (i >= j) ? sEg[i] * sRk[j] * dec * g2[nj][r] : 0.f;
          const int s = j >> 4, q = j & 15, e = (q >> 3) * 4 + (q & 3), hh = (q >> 2) & 1, ln = (i & 31) + 32 * hh;
          sq[((gmi * 4 + s) * 64 + ln) * 8 + e] = (bf16_t)f2bf(val);
        }
      }
    __syncthreads();
#pragma unroll
    for (int c = 0; c < 2; ++c) { const int o = tid + 256 * c; *(u32x4*)(ATT + (size_t)task * 4096 + (size_t)o * 8) = *(const u32x4*)(sq + o * 8); }
    typedef float f32x2 __attribute__((ext_vector_type(2)));
    f32x2 xv[32];
    {
      const bool isV = tid < 128;
      const bf16_t* src = isV ? (sv + tid) : (sk + (tid - 128));
      const float* scl = isV ? sBeta : sBk;
#pragma unroll
      for (int i = 0; i < 64; ++i) {
        f32x2 r0 = {bf2f(src[i * 136]) * scl[i], 0.f}, r1 = {0.f, 0.f};
#pragma unroll
        for (int m = 0; m < i / 2; ++m) {
          const f32x2 a2 = *(const f32x2*)(sAm + i * 68 + 2 * m);
          if (m & 1) r1 -= a2 * xv[m]; else r0 -= a2 * xv[m];
        }
        r0 += r1;
        float r = r0[0] + r0[1];
        if (i & 1) r -= sAm[i * 68 + i - 1] * xv[i / 2][0];
        xv[i / 2][i & 1] = r;
      }
    }
#define XS(i) xv[(i) >> 1][(i) & 1]
    __syncthreads();
    if (tid < 128) {
      const int s = tid >> 5, nn = tid & 31;
#pragma unroll
      for (int i = 0; i < 64; ++i) {
        const int mt = i >> 5, ii = i & 31, hh = (ii >> 2) & 1, r = (ii >> 3) * 4 + (ii & 3);
        sv[((s * 2 + mt) * 64 + nn + 32 * hh) * 16 + r] = (bf16_t)f2bf(XS(i));
      }
    } else {
      const int c = tid - 128, s = c >> 4, q = c & 15, e = (q >> 3) * 4 + (q & 3), hh = (q >> 2) & 1;
#pragma unroll
      for (int i = 0; i < 64; ++i) {
        const int mt = i >> 5;
        sk[((mt * 8 + s) * 64 + (i & 31) + 32 * hh) * 8 + e] = (bf16_t)f2bf(XS(i));
      }
    }
    __syncthreads();
#pragma unroll
    for (int c = 0; c < 4; ++c) {
      const int o = tid + 256 * c;
      *(u32x4*)(Ug + (size_t)task * 8192 + (size_t)o * 8) = *(const u32x4*)(sv + o * 8);
      *(u32x4*)(Wg + (size_t)task * 8192 + (size_t)o * 8) = *(const u32x4*)(sk + o * 8);
    }
    __syncthreads();
  }
  }
}

DI void gdn_scan(const Params& p, char* smem) {
  if (blockIdx.x >= 256) return;
  const int tid = otid(), lane = tid & 63, wave = __builtin_amdgcn_readfirstlane(tid >> 6);
  const int xcd = blockIdx.x & 7, yy = blockIdx.x >> 3;
  const int bh = xcd * 8 + (yy >> 2), s = yy & 3, h = bh & 7, b = bh >> 3;
  bf16x8* Sfrag = (bf16x8*)smem;
  bf16x8* Vfrag = Sfrag + 512;
  const bf16_t* Ug = (const bf16_t*)(p.ws + WS_U); const bf16_t* Wg = (const bf16_t*)(p.ws + WS_W); const bf16_t* ATT = (const bf16_t*)(p.ws + WS_ATTN);
  const bf16_t* QG = (const bf16_t*)(p.out + OUT_SSS); const bf16_t* KT = QG + (size_t)2048 * 8192;
  const float* GL = (const float*)(p.ws + WS_GL);
  bf16_t* O = (bf16_t*)(p.ws + WS_O);
  const size_t cbase = (size_t)(b * 8 + h) * 32;
  const bool isW = wave < 2; const int mi = wave & 1;
  f32x16 S;
#pragma unroll
  for (int i = 0; i < 16; ++i) S[i] = 0.f;
  { bf16x8 z; for (int e = 0; e < 8; ++e) z[e] = 0; for (int o = tid; o < 512; o += 256) Sfrag[o] = z; }
  const bf16_t* aBase = (isW ? Wg : QG) + cbase * 8192 + (size_t)(mi * 8) * 512 + lane * 8;
  const bf16_t* kBase = KT + cbase * 8192 + (size_t)(wave * 4) * 512 + lane * 8;
  const bf16_t* tBase = ATT + cbase * 4096 + (size_t)(mi * 4) * 512 + lane * 8;
  const bf16_t* uBase = Ug + cbase * 8192 + (size_t)((s * 2 + mi) * 64 + lane) * 16;
  struct Regs { bf16x8 afr[8], kfr[4], tfr[4]; u32x4 ur[2]; };
  const float glv = GL[cbase + (lane & 31)];
  Regs R0, R1;
  auto load_all = [&](Regs& R, int n) {
#pragma unroll
    for (int ks = 0; ks < 8; ++ks) R.afr[ks] = *(const bf16x8*)(aBase + (size_t)n * 8192 + ks * 512);
#pragma unroll
    for (int k4 = 0; k4 < 4; ++k4) { R.kfr[k4] = *(const bf16x8*)(kBase + (size_t)n * 8192 + k4 * 512); R.tfr[k4] = *(const bf16x8*)(tBase + (size_t)n * 4096 + k4 * 512); }
    R.ur[0] = *(const u32x4*)(uBase + (size_t)n * 8192); R.ur[1] = *(const u32x4*)(uBase + (size_t)n * 8192 + 8);
  };
  load_all(R0, 0);
  load_all(R1, 1);
  __syncthreads();
  auto step = [&](Regs& R, const int n) {
    const int nn = n + 2 < 32 ? n + 2 : 31;
    f32x16 acc0, acc1;
#pragma unroll
    for (int i = 0; i < 16; ++i) { acc0[i] = 0.f; acc1[i] = 0.f; }
#pragma unroll
    for (int ks = 0; ks < 8; ks += 2) {
      acc0 = MFMA32(R.afr[ks], Sfrag[ks * 64 + lane], acc0);
      acc1 = MFMA32(R.afr[ks + 1], Sfrag[(ks + 1) * 64 + lane], acc1);
    }
#pragma unroll
    for (int i = 0; i < 16; ++i) acc0[i] += acc1[i];
#pragma unroll
    for (int ks = 0; ks < 8; ++ks) R.afr[ks] = *(const bf16x8*)(aBase + (size_t)nn * 8192 + ks * 512);
    if (isW) {
      f32x16 vn;
#pragma unroll
      for (int e = 0; e < 4; ++e) {
        vn[2 * e] = bflo(R.ur[0][e]) - acc0[2 * e]; vn[2 * e + 1] = bfhi(R.ur[0][e]) - acc0[2 * e + 1];
        vn[8 + 2 * e] = bflo(R.ur[1][e]) - acc0[8 + 2 * e]; vn[8 + 2 * e + 1] = bfhi(R.ur[1][e]) - acc0[8 + 2 * e + 1];
      }
      Vfrag[(2 * mi) * 64 + lane] = pack8(vn, 0);
      Vfrag[(2 * mi + 1) * 64 + lane] = pack8(vn, 1);
      R.ur[0] = *(const u32x4*)(uBase + (size_t)nn * 8192); R.ur[1] = *(const u32x4*)(uBase + (size_t)nn * 8192 + 8);
    }
    lds_barrier();
    if (!isW) {
#pragma unroll
      for (int k4 = 0; k4 < 4; ++k4) acc0 = MFMA32(R.tfr[k4], Vfrag[k4 * 64 + lane], acc0);
      bf16_t* op = O + (size_t)(b * 2048 + n * 64 + mi * 32) * 1024 + h * 128 + s * 32 + (lane & 30);
#pragma unroll
      for (int ip = 0; ip < 8; ++ip) *(unsigned*)(op + (size_t)rowi(2 * ip + (lane & 1), lane) * 1024) = pair_pk(acc0[2 * ip], acc0[2 * ip + 1], lane);
#pragma unroll
      for (int k4 = 0; k4 < 4; ++k4) R.tfr[k4] = *(const bf16x8*)(tBase + (size_t)nn * 4096 + k4 * 512);
    }
    const float gl = __builtin_bit_cast(float, __builtin_amdgcn_readlane(__builtin_bit_cast(int, glv), n));
#pragma unroll
    for (int i = 0; i < 16; ++i) S[i] *= gl;
#pragma unroll
    for (int k4 = 0; k4 < 4; ++k4) S = MFMA32(R.kfr[k4], Vfrag[k4 * 64 + lane], S);
#pragma unroll
    for (int k4 = 0; k4 < 4; ++k4) R.kfr[k4] = *(const bf16x8*)(kBase + (size_t)nn * 8192 + k4 * 512);
    Sfrag[(2 * wave) * 64 + lane] = pack8(S, 0);
    Sfrag[(2 * wave + 1) * 64 + lane] = pack8(S, 1);
    lds_barrier();
  };
#pragma unroll 1
  for (int n = 0; n < 32; n += 2) { step(R0, n); step(R1, n + 1); }
  float* so = p.out + OUT_SSP + ((size_t)(b * 8 + h) * 128 + wave * 32) * 128 + s * 32 + (lane & 31);
#pragma unroll
  for (int r = 0; r < 16; ++r) so[(size_t)rowi(r, lane) * 128] = S[r];
}

DI void sample_task(const Params& p, char* smem, int task) {
  const int tid = otid(), lane = tid & 63, wave = tid >> 6;
  const int bs = task >> 3, h = task & 7;
  float* fq = (float*)smem; float* fk = fq + 1024; float* fv = fk + 1024; float* red = fv + 1024; float* ored = red + 2048; float* scal = ored + 2048;
  const bf16_t* QKV = (const bf16_t*)(p.ws + WS_QKV); const float* BA = (const float*)(p.ws + WS_BA);
  const bf16_t* Z = (const bf16_t*)(p.ws + WS_Z); bf16_t* AB = (bf16_t*)(p.ws + WS_ABUF);
  const int rowb = MP + bs * 8;
#pragma unroll
  for (int it = 0; it < 12; ++it) {
    const int idx = tid + 256 * it;
    const int tok = idx / 384, cc = idx - tok * 384, seg = cc >> 7, c = cc & 127, col = seg * 1024 + h * 128 + c;
    float acc = 0.f;
#pragma unroll
    for (int j = 0; j < 4; ++j) {
      const int tt = tok + j;
      const float xs = p.st_conv_b[((size_t)bs * 3 + (tt < 3 ? tt : 2)) * 3072 + col];
      const float xq = bf2f(QKV[(size_t)(rowb + (tt >= 3 ? tt - 3 : 0)) * 3072 + col]);
      acc += p.wb_conv[j * 3072 + col] * (tt < 3 ? xs : xq);
    }
    (seg == 0 ? fq : (seg == 1 ? fk : fv))[tok * 128 + c] = silu(acc);
  }
  if (tid < 8) {
    const int row = rowb + tid;
    const float bb = BA[(size_t)row * 16 + h], aa = BA[(size_t)row * 16 + 8 + h];
    const float xx = aa + p.wb_dt_bias[h];
    const float sp = xx > 20.f ? xx : log1pf(expf(xx));
    scal[tid] = 1.f / (1.f + expf(-bb));
    scal[8 + tid] = expf(-expf(p.wb_a_log[h]) * sp);
  }
  __syncthreads();
#pragma unroll
  for (int rr = 0; rr < 4; ++rr) {
    const int r16 = wave * 4 + rr;
    float* ptr = r16 < 8 ? fq + r16 * 128 : fk + (r16 - 8) * 128;
    const float a0 = ptr[lane], a1 = ptr[lane + 64];
    float ss = a0 * a0 + a1 * a1;
#pragma unroll
    for (int o = 32; o >= 1; o >>= 1) ss += __shfl_xor(ss, o);
    const float f = rsqrtf(ss + 1e-6f) * (r16 < 8 ? 0.08838834764831845f : 1.f);
    ptr[lane] = a0 * f; ptr[lane + 64] = a1 * f;
  }
  __syncthreads();
  const int vcol = tid & 127, kh = tid >> 7;
  float S[64];
  {
    const float* sp = p.st_ssm + (((size_t)bs * 8 + h) * 128 + kh * 64) * 128 + vcol;
#pragma unroll
    for (int kk = 0; kk < 64; ++kk) S[kk] = __builtin_nontemporal_load(sp + (size_t)kk * 128);
  }
#pragma unroll 1
  for (int t = 0; t < 8; ++t) {
    const float* kt = fk + t * 128 + kh * 64;
    const float* qt = fq + t * 128 + kh * 64;
    float part = 0.f;
#pragma unroll
    for (int kk = 0; kk < 64; ++kk) part += kt[kk] * S[kk];
    red[(t * 2 + kh) * 128 + vcol] = part;
    __syncthreads();
    const float kS = red[(t * 2) * 128 + vcol] + red[(t * 2 + 1) * 128 + vcol];
    const float a = scal[8 + t], be = scal[t];
    const float d = be * (fv[t * 128 + vcol] - a * kS);
    float op = 0.f;
#pragma unroll
    for (int kk = 0; kk < 64; ++kk) { S[kk] = a * S[kk] + kt[kk] * d; op += qt[kk] * S[kk]; }
    ored[(t * 2 + kh) * 128 + vcol] = op;
  }
  {
    float* so = p.out + OUT_SSS + (((size_t)bs * 8 + h) * 128 + kh * 64) * 128 + vcol;
#pragma unroll
    for (int kk = 0; kk < 64; ++kk) __builtin_nontemporal_store(S[kk], so + (size_t)kk * 128);
  }
  __syncthreads();
  {
    const int tok = tid >> 5, c4 = (tid & 31) * 4;
    float o[4]; float ss = 0.f;
#pragma unroll
    for (int e = 0; e < 4; ++e) { o[e] = ored[(tok * 2) * 128 + c4 + e] + ored[(tok * 2 + 1) * 128 + c4 + e]; ss += o[e] * o[e]; }
#pragma unroll
    for (int o2 = 16; o2 >= 1; o2 >>= 1) ss += __shfl_xor(ss, o2);
    const float rstd = rsqrtf(ss * (1.f / 128.f) + 1e-6f);
    const u32x2 zr = *(const u32x2*)(Z + (size_t)(rowb + tok) * 1024 + h * 128 + c4);
    const float z0 = bflo(zr[0]), z1 = bfhi(zr[0]), z2 = bflo(zr[1]), z3 = bfhi(zr[1]);
    u32x2 ov;
    ov[0] = pk2(o[0] * rstd * p.wb_norm[c4] * silu(z0), o[1] * rstd * p.wb_norm[c4 + 1] * silu(z1));
    ov[1] = pk2(o[2] * rstd * p.wb_norm[c4 + 2] * silu(z2), o[3] * rstd * p.wb_norm[c4 + 3] * silu(z3));
    *(u32x2*)(AB + (size_t)(rowb + tok) * 1024 + h * 128 + c4) = ov;
  }
  __syncthreads();
}

DI void phase9(const Params& p, char* smem) {
  const int tid9 = otid();
  const int lane = tid9 & 63, wave = tid9 >> 6;
  const bf16_t* O = (const bf16_t*)(p.ws + WS_O); const bf16_t* Z = (const bf16_t*)(p.ws + WS_Z); bf16_t* AB = (bf16_t*)(p.ws + WS_ABUF);
  for (int task = blockIdx.x; task < 2048; task += gridDim.x) {
    if (task < 1024) { sample_task(p, smem, task); continue; }
    const int r0 = (task - 1024) * 16 + wave * 4;
#pragma unroll
    for (int rr = 0; rr < 4; ++rr) {
      const int row = r0 + rr;
#pragma unroll
      for (int j = 0; j < 4; ++j) {
        const int col = j * 256 + lane * 4;
        const u32x2 orw = __builtin_nontemporal_load((const u32x2*)(O + (size_t)row * 1024 + col));
        f32x4 o4; o4[0] = bflo(orw[0]); o4[1] = bfhi(orw[0]); o4[2] = bflo(orw[1]); o4[3] = bfhi(orw[1]);
        float ss = o4[0] * o4[0] + o4[1] * o4[1] + o4[2] * o4[2] + o4[3] * o4[3];
#pragma unroll
        for (int o2 = 16; o2 >= 1; o2 >>= 1) ss += __shfl_xor(ss, o2);
        const float rstd = rsqrtf(ss * (1.f / 128.f) + 1e-6f);
        const u32x2 zr = __builtin_nontemporal_load((const u32x2*)(Z + (size_t)row * 1024 + col));
        const f32x4 nw = *(const f32x4*)(p.wb_norm + (col & 127));
        u32x2 ov;
        ov[0] = pk2(o4[0] * rstd * nw[0] * silu(bflo(zr[0])), o4[1] * rstd * nw[1] * silu(bfhi(zr[0])));
        ov[1] = pk2(o4[2] * rstd * nw[2] * silu(bflo(zr[1])), o4[3] * rstd * nw[3] * silu(bfhi(zr[1])));
        *(u32x2*)(AB + (size_t)row * 1024 + col) = ov;
      }
    }
  }
}

__global__ void __launch_bounds__(256, 2) fwd_megakernel(Params p) {
  extern __shared__ __attribute__((aligned(16))) char smem[];
  cg::grid_group grid = cg::this_grid();
  if (p.out == nullptr) grid.sync();
  __shared__ uint4 xb_words;
  if (threadIdx.x == 0) xb_words = make_uint4(0u, 0u, 0u, 0u);
  __syncthreads();
  XcdBarrier xb = xcd_barrier_post((unsigned*)(p.ws + WS_BAR), (volatile LAS unsigned*)&xb_words);
#define GSYNC() xcd_barrier(xb)
  phase0a(p);
  GSYNC();
  phase0(p, smem);
  GSYNC();
  phase1(p);
  GSYNC();
  { Epi1<4> e{(bf16_t*)(p.ws + WS_CH), (bf16_t*)(p.ws + WS_G1), p.out}; gemm_phase<4>((const bf16_t*)(p.ws + WS_ABUF), (const bf16_t*)(p.ws + WS_WT1), 32, smem, e); }
  GSYNC();
  phase3(p);
  GSYNC();
  { Epi2<2> e{p}; gemm_phase<2>((const bf16_t*)(p.ws + WS_ABUF), (const bf16_t*)(p.ws + WS_WT2), 8, smem, e); }
  GSYNC();
  ln_phase<0>(p);
  GSYNC();
  { Epi3<4> e{p}; gemm_phase<4>((const bf16_t*)(p.ws + WS_ABUF), (const bf16_t*)(p.ws + WS_WT3), 33, smem, e); }
  GSYNC();
  gdn_chunk_local(p, smem);
  GSYNC();
  gdn_scan(p, smem);
  GSYNC();
  phase9(p, smem);
  GSYNC();
  { Epi4<2> e{p}; gemm_phase<2>((const bf16_t*)(p.ws + WS_ABUF), (const bf16_t*)(p.ws + WS_WT4), 8, smem, e); }
  GSYNC();
  ln_phase<1>(p);
}

extern "C" void kernel_launch(void* const* d_in, const int* in_sizes, int n_in, void* d_out, int out_size, void* d_ws, size_t ws_size, hipStream_t stream) {
  static int grid_blocks = 0;
  if (!grid_blocks) {
    int dev = 0, cus = 0, per_cu = 0;
    hipGetDevice(&dev);
    hipDeviceGetAttribute(&cus, hipDeviceAttributeMultiprocessorCount, dev);
    hipFuncSetAttribute((const void*)fwd_megakernel, hipFuncAttributeMaxDynamicSharedMemorySize, LDS_BYTES);
    hipOccupancyMaxActiveBlocksPerMultiprocessor(&per_cu, (const void*)fwd_megakernel, 256, LDS_BYTES);
    if (per_cu < 1) per_cu = 1;
    if (per_cu > 2) per_cu = 2;
    grid_blocks = cus * per_cu;
    if (ws_size < 247 * MiB) fprintf(stderr, "kernel_launch: workspace too small: %zu\n", ws_size);
  }
  Params p{};
  const float** pp = (const float**)&p;
  for (int i = 0; i < 20; ++i) pp[i] = (const float*)d_in[i];
  p.out = (float*)d_out; p.ws = (char*)d_ws;
  hipMemsetAsync((char*)d_ws + WS_BAR, 0, XCD_BAR_WORDS * 4, stream);
  void* args[] = {&p};
  hipError_t e = hipLaunchCooperativeKernel((const void*)fwd_megakernel, dim3(grid_blocks), dim3(256), args, LDS_BYTES, stream);
  if (e != hipSuccess) fprintf(stderr, "cooperative launch failed: %s (grid %d)\n", hipGetErrorString(e), grid_blocks);
}
```

```cpp
#include <hip/hip_runtime.h>
#include <hip/hip_cooperative_groups.h>
#include <cstdio>
namespace cg = cooperative_groups;

typedef unsigned short bf16_t;
typedef short bf16x8 __attribute__((ext_vector_type(8)));
typedef float f32x16 __attribute__((ext_vector_type(16)));
typedef float f32x4 __attribute__((ext_vector_type(4)));
typedef unsigned u32x4 __attribute__((ext_vector_type(4)));
typedef unsigned u32x2 __attribute__((ext_vector_type(2)));

#define DI __device__ __forceinline__
#define MFMA32(a, b, c) __builtin_amdgcn_mfma_f32_32x32x16_bf16((a), (b), (c), 0, 0, 0)

constexpr int MTOT = 17408, MP = 16384;
constexpr size_t MiB = 1ull << 20;
constexpr size_t WS_WT1 = 0, WS_WT2 = 8 * MiB, WS_WT3 = 10 * MiB, WS_WT4 = 19 * MiB, WS_MOD = 21 * MiB, WS_STATS = 25 * MiB,
                 WS_BA = 25 * MiB + 512 * 1024, WS_GL = 26 * MiB + 768 * 1024, WS_BAR = 26 * MiB + 832 * 1024, WS_CST = 24 * MiB + 256 * 1024, WS_ABUF = 27 * MiB, WS_CH = 61 * MiB, WS_G1 = 95 * MiB,
                 WS_QKV = 129 * MiB, WS_ATTN = 231 * MiB;
constexpr size_t WS_U = WS_ABUF, WS_Z = WS_CH, WS_W = WS_G1, WS_O = WS_QKV;
constexpr size_t OUT_Y = 0, OUT_CAP = 17825792, OUT_CBP = 17842176, OUT_SSP = 17915904, OUT_CAS = 18964480, OUT_CBS = 19226624, OUT_SSS = 20406272;
constexpr int LDS_BYTES = 72192;
constexpr float ALPHA_F = 1.41421356237309515f;

struct Params {
  const float *x_p, *x_s, *st_conv_a, *st_conv_b, *st_ssm, *c_p, *c_s, *w_mod, *b_mod, *ln_g, *ln_b, *wa_in, *wa_conv, *wa_out, *wb_in, *wb_conv,
      *wb_a_log, *wb_dt_bias, *wb_norm, *wb_out;
  float* out;
  char* ws;
};

typedef float f32x2v __attribute__((ext_vector_type(2)));
typedef __bf16 bf16x2v __attribute__((ext_vector_type(2)));
DI unsigned pk2(float lo, float hi) { f32x2v v = {lo, hi}; bf16x2v b = __builtin_convertvector(v, bf16x2v); return __builtin_bit_cast(unsigned, b); }
DI unsigned f2bf(float x) { __bf16 b = (__bf16)x; return (unsigned)__builtin_bit_cast(unsigned short, b); }
DI float bflo(unsigned u) { return __uint_as_float(u << 16); }
DI float bfhi(unsigned u) { return __uint_as_float(u & 0xffff0000u); }
DI float bf2f(bf16_t v) { return __uint_as_float(((unsigned)v) << 16); }
DI float silu(float x) { return x * __builtin_amdgcn_rcpf(1.f + __expf(-x)); }
DI int otid() { int t = threadIdx.x; asm volatile("" : "+v"(t)); return t; }
DI int rowi(int i, int lane) { return (i & 3) + 8 * (i >> 2) + 4 * (lane >> 5); }
DI int bidx(int row) { return row < MP ? (row >> 11) : 8 + ((row - MP) >> 3); }
DI const float* xrow(const Params& p, int row) { return row < MP ? p.x_p + (size_t)row * 1024 : p.x_s + (size_t)(row - MP) * 1024; }
DI bf16x8 pack8(const f32x16& x, int s) {
  u32x4 r;
  r[0] = pk2(x[8 * s + 0], x[8 * s + 1]); r[1] = pk2(x[8 * s + 2], x[8 * s + 3]); r[2] = pk2(x[8 * s + 4], x[8 * s + 5]); r[3] = pk2(x[8 * s + 6], x[8 * s + 7]);
  return __builtin_bit_cast(bf16x8, r);
}


#define XB_TMO      128
#define XB_XCNT(j)  (256  + 64 * (j))
#define XB_XSUB(j)  (1280 + 64 * (j))
#define XB_XGEN(j)  (2304 + 64 * (j))
#define XB_TOP      3328
#define XB_TOPGEN   3392
#define XCD_BAR_WORDS 3456
#define XB_SPIN_CAP (1u << 18)
#define LAS __attribute__((address_space(3)))
DI unsigned xb_ld(unsigned* p) { return __hip_atomic_load(p, __ATOMIC_RELAXED, __HIP_MEMORY_SCOPE_AGENT); }
DI unsigned xb_add(unsigned* p, unsigned v) { return __hip_atomic_fetch_add(p, v, __ATOMIC_RELAXED, __HIP_MEMORY_SCOPE_AGENT); }
DI unsigned xb_xcc_id() { return (unsigned)__builtin_amdgcn_s_getreg((3 << 11) | 20) & 0xFu; }
#define XB_SPIN(cond, bar) do { unsigned _sp = 0; while (cond) { __builtin_amdgcn_s_sleep(1); \
    if ((++_sp & 255u) == 0u) { if (xb_ld(&(bar)[XB_TMO])) break; if (_sp > XB_SPIN_CAP) { atomicAdd(&(bar)[XB_TMO], 1u); break; } } } } while (0)
struct XcdBarrier { unsigned* bar; unsigned x; volatile LAS unsigned* st; };
DI XcdBarrier xcd_barrier_post(unsigned* bar, volatile LAS unsigned* st) {
  XcdBarrier b; b.bar = bar; b.x = xb_xcc_id(); b.st = st;
  if (threadIdx.x == 0) (void)xb_add(&bar[XB_XCNT(b.x)], 1u);
  return b;
}
DI void xcd_barrier_complete(unsigned* bar, unsigned x, unsigned& nloc, unsigned& nx) {
  const unsigned G = gridDim.x * gridDim.y * gridDim.z;
  unsigned sum, cnt, mine, sp = 0u;
  for (;;) {
    sum = 0u; cnt = 0u; mine = 0u;
#pragma unroll
    for (unsigned j = 0; j < 16; ++j) { const unsigned c = xb_ld(&bar[XB_XCNT(j)]); sum += c; cnt += (c > 0u) ? 1u : 0u; mine = (j == x) ? c : mine; }
    if (sum == G) break;
    __builtin_amdgcn_s_sleep(1);
    if ((++sp & 255u) == 0u) { if (xb_ld(&bar[XB_TMO])) break; if (sp > XB_SPIN_CAP) { atomicAdd(&bar[XB_TMO], 1u); break; } }
  }
  nloc = mine > 0u ? mine : 1u; nx = cnt > 0u ? cnt : 1u;
}
DI void xcd_barrier(const XcdBarrier& b) {
  asm volatile("s_waitcnt vmcnt(0)" ::: "memory");
  __syncthreads();
  if (threadIdx.x == 0) {
    unsigned* bar = b.bar;
    __builtin_amdgcn_s_waitcnt(0);
    unsigned nloc = b.st[0], nx = b.st[1];
    if (nloc == 0u) { xcd_barrier_complete(bar, b.x, nloc, nx); b.st[0] = nloc; b.st[1] = nx; }
    const unsigned old = xb_add(&bar[XB_XSUB(b.x)], 1u);
    const unsigned gen = old / nloc;
    if (old + 1u == (gen + 1u) * nloc) {
      __builtin_amdgcn_fence(__ATOMIC_RELEASE, "agent");
      asm volatile("s_waitcnt vmcnt(0)" ::: "memory");
      const unsigned og = xb_add(&bar[XB_TOP], 1u);
      const unsigned tg = og / nx;
      if (og + 1u == (tg + 1u) * nx) xb_add(&bar[XB_TOPGEN], 1u);
      else XB_SPIN(xb_ld(&bar[XB_TOPGEN]) == tg, bar);
      __builtin_amdgcn_fence(__ATOMIC_ACQUIRE, "agent");
      xb_add(&bar[XB_XGEN(b.x)], 1u);
      asm volatile("s_waitcnt vmcnt(0)" ::: "memory");
    } else {
      XB_SPIN(xb_ld(&bar[XB_XGEN(b.x)]) == gen, bar);
      __builtin_amdgcn_fence(__ATOMIC_ACQUIRE, "agent");
      asm volatile("s_waitcnt vmcnt(0)" ::: "memory");
    }
  }
  __syncthreads();
}
DI void lds_barrier() { asm volatile("s_waitcnt lgkmcnt(0)\n\ts_barrier" ::: "memory"); }

DI void phase0a(const Params& p) {
  float* CST = (float*)(p.ws + WS_CST);
  for (int idx = blockIdx.x * 256 + otid(); idx < 1024 * 160; idx += gridDim.x * 256) {
    const int k = idx / 160, r = idx - k * 160;
    float v = 0.f;
    if (r < 8) v = silu(p.c_p[r * 1024 + k]); else if (r < 136) v = silu(p.c_s[(r - 8) * 1024 + k]);
    CST[idx] = v;
  }
}
DI void phase0(const Params& p, char* smem) {
  float* MOD = (float*)(p.ws + WS_MOD);
  const float* CST = (const float*)(p.ws + WS_CST);
  const int nmod = gridDim.x >= 384 ? 192 : 0;
  const int tstep = gridDim.x - nmod;
  if (nmod == 0 || (int)blockIdx.x < nmod)
  for (int task = blockIdx.x; task < 192; task += gridDim.x) {
    int tid = threadIdx.x; asm volatile("" : "+v"(tid));
    {
      const int l = task / 96, cb = task % 96;
      const int lane = tid & 63, wave = tid >> 6;
      float* red = (float*)smem;
      __syncthreads();
      for (int i = tid; i < 160 * 32; i += 256) red[i] = 0.f;
      __syncthreads();
      f32x16 acc[5];
#pragma unroll
      for (int mt = 0; mt < 5; ++mt)
#pragma unroll
        for (int i = 0; i < 16; ++i) acc[mt][i] = 0.f;
      const float* wm = p.w_mod + (size_t)l * 1024 * 3072 + cb * 32 + (lane & 31) + (size_t)(wave * 256 + (lane >> 5)) * 3072;
      const float* ct = CST + (lane & 31) + (wave * 256 + (lane >> 5)) * 160;
      float bA[8], aA[8][5], bB[8], aB[8][5];
#define MOD_LOAD(bb, aa, g) { _Pragma("unroll") for (int u = 0; u < 8; ++u) { const int kk = 2 * ((g) * 8 + u); bb[u] = __builtin_nontemporal_load(wm + (size_t)kk * 3072); _Pragma("unroll") for (int mt = 0; mt < 5; ++mt) aa[u][mt] = ct[kk * 160 + mt * 32]; } }
#define MOD_COMP(bb, aa) { _Pragma("unroll") for (int u = 0; u < 8; ++u) { _Pragma("unroll") for (int mt = 0; mt < 5; ++mt) acc[mt] = __builtin_amdgcn_mfma_f32_32x32x2f32(aa[u][mt], bb[u], acc[mt], 0, 0, 0); } }
      MOD_LOAD(bA, aA, 0);
#pragma unroll 1
      for (int g = 0; g < 16; g += 2) {
        MOD_LOAD(bB, aB, g + 1);
        MOD_COMP(bA, aA);
        { const int g2 = g + 2 < 16 ? g + 2 : 15; MOD_LOAD(bA, aA, g2); }
        MOD_COMP(bB, aB);
      }
#pragma unroll
      for (int mt = 0; mt < 5; ++mt)
#pragma unroll
        for (int i = 0; i < 16; ++i) atomicAdd(&red[(mt * 32 + rowi(i, lane)) * 32 + (lane & 31)], acc[mt][i]);
      __syncthreads();
      {
        const int col = tid & 31;
        const float bm = p.b_mod[l * 3072 + cb * 32 + col];
        for (int r = tid >> 5; r < 136; r += 8) MOD[((size_t)l * 136 + r) * 3072 + cb * 32 + col] = red[r * 32 + col] + bm;
      }
    }
  }
  if ((int)blockIdx.x >= nmod) {
    {
      const int tid = threadIdx.x;
      const int TOT = (4096 + 1024 + 4224 + 1024) * 128;
      const int nthr = tstep * 256;
      for (int it0 = ((int)blockIdx.x - nmod) * 256 + tid; it0 < TOT; it0 += 2 * nthr) {
        float v[2][8]; bf16_t* dptr[2]; bool ok[2];
#pragma unroll
        for (int u = 0; u < 2; ++u) {
          int it = it0 + u * nthr; ok[u] = it < TOT; if (!ok[u]) it = it0;
          const float* src; int ldw, N, mode; bf16_t* dst;
          if (it < 4096 * 128) { src = p.wa_in; ldw = 4096; N = 4096; mode = 1; dst = (bf16_t*)(p.ws + WS_WT1); }
          else if (it < 5120 * 128) { it -= 4096 * 128; src = p.wa_out; ldw = 1024; N = 1024; mode = 0; dst = (bf16_t*)(p.ws + WS_WT2); }
          else if (it < 9344 * 128) { it -= 5120 * 128; src = p.wb_in; ldw = 4112; N = 4224; mode = 2; dst = (bf16_t*)(p.ws + WS_WT3); }
          else { it -= 9344 * 128; src = p.wb_out; ldw = 1024; N = 1024; mode = 0; dst = (bf16_t*)(p.ws + WS_WT4); }
          const int k8 = it / N, np = it - k8 * N;
          int sc = np;
          if (mode == 1) { const int nt128 = np >> 7, seg = (np >> 5) & 3, j = np & 31; sc = (seg == 0 ? 1024 : seg == 1 ? 2048 : seg == 2 ? 0 : 3072) + nt128 * 32 + j; }
          const bool valid = !(mode == 2 && np >= 4112);
          const float* sp = src + (size_t)(k8 * 8) * ldw + (valid ? sc : 0);
#pragma unroll
          for (int j = 0; j < 8; ++j) { const float x = __builtin_nontemporal_load(sp + (size_t)j * ldw); v[u][j] = valid ? x : 0.f; }
          dptr[u] = dst + ((size_t)((np >> 5) * 64 + (k8 >> 1)) * 64 + (np & 31) + 32 * (k8 & 1)) * 8;
        }
#pragma unroll
        for (int u = 0; u < 2; ++u) if (ok[u]) {
          u32x4 o; o[0] = pk2(v[u][0], v[u][1]); o[1] = pk2(v[u][2], v[u][3]); o[2] = pk2(v[u][4], v[u][5]); o[3] = pk2(v[u][6], v[u][7]);
          *(u32x4*)dptr[u] = o;
        }
      }
    }
  }
}

DI void phase1(const Params& p) {
  const float* MOD = (const float*)(p.ws + WS_MOD);
  bf16_t* AB = (bf16_t*)(p.ws + WS_ABUF);
  for (int i = blockIdx.x * 256 + otid(); i < MTOT * 128; i += gridDim.x * 256) {
    const int row = i >> 7, c8 = (i & 127) * 8;
    const float* xr = xrow(p, row) + c8;
    const float* md = MOD + (size_t)bidx(row) * 3072 + c8;
    const f32x4 x0 = *(const f32x4*)xr, x1 = *(const f32x4*)(xr + 4);
    const f32x4 sh0 = *(const f32x4*)md, sh1 = *(const f32x4*)(md + 4), sc0 = *(const f32x4*)(md + 1024), sc1 = *(const f32x4*)(md + 1028);
    u32x4 o;
    o[0] = pk2(x0[0] * (1.f + sc0[0]) + sh0[0], x0[1] * (1.f + sc0[1]) + sh0[1]);
    o[1] = pk2(x0[2] * (1.f + sc0[2]) + sh0[2], x0[3] * (1.f + sc0[3]) + sh0[3]);
    o[2] = pk2(x1[0] * (1.f + sc1[0]) + sh1[0], x1[1] * (1.f + sc1[1]) + sh1[1]);
    o[3] = pk2(x1[2] * (1.f + sc1[2]) + sh1[2], x1[3] * (1.f + sc1[3]) + sh1[3]);
    *(u32x4*)(AB + (size_t)row * 1024 + c8) = o;
  }
}

template <int MI, class Epi>
DI void gemm_phase(const bf16_t* __restrict__ A, const bf16_t* __restrict__ Bt, const int ntN, char* smem, const Epi& epi) {
  constexpr int BM = 64 * MI;
  bf16_t* sA = (bf16_t*)smem;
  const int ntiles = (MTOT / BM) * ntN;
  for (int t = blockIdx.x; t < ntiles; t += gridDim.x) {
    const int tid = otid(), lane = tid & 63, wave = tid >> 6, wr = wave >> 1, wc = wave & 1;
    const int lrow = tid >> 3, lkc = (tid & 7) * 8;
    const int mt = t / ntN, nt = t - mt * ntN;
    const bf16_t* Ag = A + ((size_t)mt * BM + lrow) * 1024 + lkc;
    const bf16_t* Bf = Bt + (size_t)(nt * 4 + wc * 2) * 64 * 512 + lane * 8;
    f32x16 acc[MI][2];
#pragma unroll
    for (int mi = 0; mi < MI; ++mi)
#pragma unroll
      for (int nj = 0; nj < 2; ++nj)
#pragma unroll
        for (int i = 0; i < 16; ++i) acc[mi][nj][i] = 0.f;
    typename Epi::Pre pre;
    epi.prefetch(mt * BM + wr * (32 * MI), nt, wc, lane, pre);
    u32x4 ra[2 * MI];
    bf16x8 bfr[2][4];
#pragma unroll
    for (int q = 0; q < 2 * MI; ++q) ra[q] = *(const u32x4*)(Ag + (size_t)q * 32 * 1024);
#pragma unroll
    for (int nj = 0; nj < 2; ++nj)
#pragma unroll
      for (int ks = 0; ks < 4; ++ks) bfr[nj][ks] = *(const bf16x8*)(Bf + (size_t)(nj * 64 + ks) * 512);
    for (int kt = 0; kt < 16; ++kt) {
      lds_barrier();
#pragma unroll
      for (int q = 0; q < 2 * MI; ++q) *(u32x4*)(sA + (lrow + 32 * q) * 72 + lkc) = ra[q];
      lds_barrier();
      const int kn = kt < 15 ? kt + 1 : 15;
#pragma unroll
      for (int q = 0; q < 2 * MI; ++q) ra[q] = *(const u32x4*)(Ag + (size_t)q * 32 * 1024 + kn * 64);
      __builtin_amdgcn_sched_barrier(0);
      __builtin_amdgcn_s_setprio(2);
#pragma unroll
      for (int ks = 0; ks < 4; ++ks) {
        bf16x8 a[MI];
#pragma unroll
        for (int mi = 0; mi < MI; ++mi) a[mi] = *(const bf16x8*)(sA + (wr * (32 * MI) + mi * 32 + (lane & 31)) * 72 + ks * 16 + (lane >> 5) * 8);
#pragma unroll
        for (int mi = 0; mi < MI; ++mi)
#pragma unroll
          for (int nj = 0; nj < 2; ++nj) acc[mi][nj] = MFMA32(a[mi], bfr[nj][ks], acc[mi][nj]);
#pragma unroll
        for (int nj = 0; nj < 2; ++nj) bfr[nj][ks] = *(const bf16x8*)(Bf + (size_t)(nj * 64 + kn * 4 + ks) * 512);
      }
      __builtin_amdgcn_s_setprio(0);
    }
    epi(mt * BM + wr * (32 * MI), nt, wc, lane, acc, pre);
  }
}

DI unsigned pair_pk(float v0, float v1, int lane) {
  const bool odd = lane & 1;
  const float send = odd ? v0 : v1;
  const float recv = __builtin_bit_cast(float, __builtin_amdgcn_update_dpp(0, __builtin_bit_cast(int, send), 0xB1, 0xF, 0xF, true));
  return odd ? pk2(recv, v1) : pk2(v0, recv);
}
template <int MI> struct Epi1 {
  struct Pre {};
  DI void prefetch(int, int, int, int, Pre&) const {}
  bf16_t* CH; bf16_t* G1; float* out;
  template <bool TAIL> DI void body(int row0, int nt, int wc, int lane, const f32x16 (&acc)[MI][2]) const {
    const int ch = nt * 32 + (lane & 31);
    bf16_t* dst = (wc == 0 ? CH : G1) + (ch & ~1);
#pragma unroll
    for (int mi = 0; mi < MI; ++mi)
#pragma unroll
      for (int ip = 0; ip < 8; ++ip) {
        float v[2];
#pragma unroll
        for (int u = 0; u < 2; ++u) {
          const int i = 2 * ip + u;
          v[u] = wc == 0 ? acc[mi][0][i] * acc[mi][1][i] : acc[mi][0][i] * silu(acc[mi][1][i]);
          if (TAIL && wc == 0) {
            const int row = row0 + mi * 32 + rowi(i, lane);
            if (row < MP) { const int t = row & 2047; if (t >= 2046) out[OUT_CAP + (size_t)((row >> 11) * 2 + (t - 2046)) * 1024 + ch] = v[u]; }
            else { const int t = row & 7; if (t >= 6) out[OUT_CAS + (size_t)(((row - MP) >> 3) * 2 + (t - 6)) * 1024 + ch] = v[u]; }
          }
        }
        const int row = row0 + mi * 32 + rowi(2 * ip + (lane & 1), lane);
        *(unsigned*)(dst + (size_t)row * 1024) = pair_pk(v[0], v[1], lane);
      }
  }
  DI void operator()(int row0, int nt, int wc, int lane, const f32x16 (&acc)[MI][2], const Pre& pre) const {
    const bool tail = row0 >= MP || ((row0 + 32 * MI - 1) & 2047) >= 2046;
    if (tail) body<true>(row0, nt, wc, lane, acc); else body<false>(row0, nt, wc, lane, acc);
  }
};
template <int MI> struct Epi2 {
  Params p;
  struct Pre { float v[MI][2][16]; };
  DI void prefetch(int row0, int nt, int wc, int lane, Pre& pre) const {
    const float* base = xrow(p, row0 + 4 * (lane >> 5)) + nt * 128 + wc * 64 + (lane & 31);
#pragma unroll
    for (int mi = 0; mi < MI; ++mi)
#pragma unroll
      for (int i = 0; i < 16; ++i)
#pragma unroll
        for (int nj = 0; nj < 2; ++nj) pre.v[mi][nj][i] = __builtin_nontemporal_load(base + (mi * 32 + (i & 3) + 8 * (i >> 2)) * 1024 + nj * 32);
  }
  template <bool PROMPT> DI void body(int row0, int nt, int wc, int lane, const f32x16 (&acc)[MI][2], const Pre& pre) const {
    const float* MOD = (const float*)(p.ws + WS_MOD);
    const int c0 = nt * 128 + wc * 64 + (lane & 31);
    float g0 = 0.f, g1 = 0.f;
    if (PROMPT) { const float* gt = MOD + (size_t)(row0 >> 11) * 3072 + 2048 + c0; g0 = gt[0]; g1 = gt[32]; }
#pragma unroll
    for (int mi = 0; mi < MI; ++mi)
#pragma unroll
      for (int i = 0; i < 16; ++i) {
        const int row = row0 + mi * 32 + rowi(i, lane);
        if (!PROMPT) { const float* gt = MOD + (size_t)bidx(row) * 3072 + 2048 + c0; g0 = gt[0]; g1 = gt[32]; }
        float* yp = p.out + OUT_Y + (size_t)row * 1024 + c0;
        yp[0] = ALPHA_F * pre.v[mi][0][i] + g0 * acc[mi][0][i];
        yp[32] = ALPHA_F * pre.v[mi][1][i] + g1 * acc[mi][1][i];
      }
  }
  DI void operator()(int row0, int nt, int wc, int lane, const f32x16 (&acc)[MI][2], const Pre& pre) const {
    if (row0 < MP) body<true>(row0, nt, wc, lane, acc, pre); else body<false>(row0, nt, wc, lane, acc, pre);
  }
};
template <int MI> struct Epi3 {
  Params p;
  struct Pre {};
  DI void prefetch(int, int, int, int, Pre&) const {}
  template <bool TAIL> DI void body(int row0, int nt, int wc, int lane, const f32x16 (&acc)[MI][2]) const {
    bf16_t* QKV = (bf16_t*)(p.ws + WS_QKV); bf16_t* Z = (bf16_t*)(p.ws + WS_Z); float* BA = (float*)(p.ws + WS_BA);
    if (nt < 32) {
#pragma unroll
      for (int nj = 0; nj < 2; ++nj) {
        const int col = nt * 128 + wc * 64 + nj * 32 + (lane & 31);
        bf16_t* dst = nt < 24 ? QKV + (col & ~1) : Z + ((col - 3072) & ~1);
        const int ld = nt < 24 ? 3072 : 1024;
#pragma unroll
        for (int mi = 0; mi < MI; ++mi)
#pragma unroll
          for (int ip = 0; ip < 8; ++ip) {
            if (TAIL && nt < 24) {
#pragma unroll
              for (int u = 0; u < 2; ++u) {
                const int row = row0 + mi * 32 + rowi(2 * ip + u, lane);
                const float v = acc[mi][nj][2 * ip + u];
                if (row < MP) { const int t = row & 2047; if (t >= 2045) p.out[OUT_CBP + (size_t)((row >> 11) * 3 + (t - 2045)) * 3072 + col] = v; }
                else { const int t = row & 7; if (t >= 5) p.out[OUT_CBS + (size_t)(((row - MP) >> 3) * 3 + (t - 5)) * 3072 + col] = v; }
              }
            }
            const int row = row0 + mi * 32 + rowi(2 * ip + (lane & 1), lane);
            *(unsigned*)(dst + (size_t)row * ld) = pair_pk(acc[mi][nj][2 * ip], acc[mi][nj][2 * ip + 1], lane);
          }
      }
    } else if (wc == 0 && (lane & 31) < 16) {
#pragma unroll
      for (int mi = 0; mi < MI; ++mi)
#pragma unroll
        for (int i = 0; i < 16; ++i) BA[(size_t)(row0 + mi * 32 + rowi(i, lane)) * 16 + (lane & 31)] = acc[mi][0][i];
    }
  }
  DI void operator()(int row0, int nt, int wc, int lane, const f32x16 (&acc)[MI][2], const Pre& pre) const {
    const bool tail = row0 >= MP || ((row0 + 32 * MI - 1) & 2047) >= 2045;
    if (tail) body<true>(row0, nt, wc, lane, acc); else body<false>(row0, nt, wc, lane, acc);
  }
};
template <int MI> struct Epi4 {
  Params p;
  struct Pre { float v[MI][2][16]; };
  DI void prefetch(int row0, int nt, int wc, int lane, Pre& pre) const {
    const float* base = p.out + OUT_Y + (size_t)(row0 + 4 * (lane >> 5)) * 1024 + nt * 128 + wc * 64 + (lane & 31);
#pragma unroll
    for (int mi = 0; mi < MI; ++mi)
#pragma unroll
      for (int i = 0; i < 16; ++i)
#pragma unroll
        for (int nj = 0; nj < 2; ++nj) pre.v[mi][nj][i] = __builtin_nontemporal_load(base + (mi * 32 + (i & 3) + 8 * (i >> 2)) * 1024 + nj * 32);
  }
  template <bool PROMPT> DI void body(int row0, int nt, int wc, int lane, const f32x16 (&acc)[MI][2], const Pre& pre) const {
    const float* MOD = (const float*)(p.ws + WS_MOD) + (size_t)136 * 3072;
    const float* ST = (const float*)(p.ws + WS_STATS);
    const int c0 = nt * 128 + wc * 64 + (lane & 31);
    const float lg0 = p.ln_g[c0], lg1 = p.ln_g[c0 + 32], lb0 = p.ln_b[c0], lb1 = p.ln_b[c0 + 32];
    float g0 = 0.f, g1 = 0.f;
    if (PROMPT) { const float* gt = MOD + (size_t)(row0 >> 11) * 3072 + 2048 + c0; g0 = gt[0]; g1 = gt[32]; }
#pragma unroll
    for (int mi = 0; mi < MI; ++mi)
#pragma unroll
      for (int i = 0; i < 16; ++i) {
        const int row = row0 + mi * 32 + rowi(i, lane);
        const float mu = ST[row * 2], rstd = ST[row * 2 + 1];
        if (!PROMPT) { const float* gt = MOD + (size_t)bidx(row) * 3072 + 2048 + c0; g0 = gt[0]; g1 = gt[32]; }
        float* yp = p.out + OUT_Y + (size_t)row * 1024 + c0;
        yp[0] = ALPHA_F * ((pre.v[mi][0][i] - mu) * rstd * lg0 + lb0) + g0 * acc[mi][0][i];
        yp[32] = ALPHA_F * ((pre.v[mi][1][i] - mu) * rstd * lg1 + lb1) + g1 * acc[mi][1][i];
      }
  }
  DI void operator()(int row0, int nt, int wc, int lane, const f32x16 (&acc)[MI][2], const Pre& pre) const {
    if (row0 < MP) body<true>(row0, nt, wc, lane, acc, pre); else body<false>(row0, nt, wc, lane, acc, pre);
  }
};

DI void phase3(const Params& p) {
  const bf16_t* CH = (const bf16_t*)(p.ws + WS_CH); const bf16_t* G1 = (const bf16_t*)(p.ws + WS_G1);
  bf16_t* AB = (bf16_t*)(p.ws + WS_ABUF);
  for (int i = blockIdx.x * 256 + otid(); i < MTOT * 128; i += gridDim.x * 256) {
    const int row = i >> 7, c8 = (i & 127) * 8;
    const bool smp = row >= MP;
    const int t = smp ? (row & 7) : (row & 2047);
    float cur[8], p1[8], p2[8], g[8];
    { const u32x4 r = *(const u32x4*)(CH + (size_t)row * 1024 + c8);
#pragma unroll
      for (int e = 0; e < 4; ++e) { cur[2 * e] = bflo(r[e]); cur[2 * e + 1] = bfhi(r[e]); } }
    { const u32x4 r = __builtin_nontemporal_load((const u32x4*)(G1 + (size_t)row * 1024 + c8));
#pragma unroll
      for (int e = 0; e < 4; ++e) { g[2 * e] = bflo(r[e]); g[2 * e + 1] = bfhi(r[e]); } }
    if (t >= 1) { const u32x4 r = *(const u32x4*)(CH + (size_t)(row - 1) * 1024 + c8);
#pragma unroll
      for (int e = 0; e < 4; ++e) { p1[2 * e] = bflo(r[e]); p1[2 * e + 1] = bfhi(r[e]); } }
    else if (smp) { const float* b = p.st_conv_a + ((size_t)((row - MP) >> 3) * 2 + 1) * 1024 + c8;
#pragma unroll
      for (int e = 0; e < 8; ++e) p1[e] = b[e]; }
    else {
#pragma unroll
      for (int e = 0; e < 8; ++e) p1[e] = 0.f; }
    if (t >= 2) { const u32x4 r = *(const u32x4*)(CH + (size_t)(row - 2) * 1024 + c8);
#pragma unroll
      for (int e = 0; e < 4; ++e) { p2[2 * e] = bflo(r[e]); p2[2 * e + 1] = bfhi(r[e]); } }
    else if (smp) { const float* b = p.st_conv_a + ((size_t)((row - MP) >> 3) * 2 + t) * 1024 + c8;
#pragma unroll
      for (int e = 0; e < 8; ++e) p2[e] = b[e]; }
    else {
#pragma unroll
      for (int e = 0; e < 8; ++e) p2[e] = 0.f; }
    float o[8];
#pragma unroll
    for (int e = 0; e < 8; ++e) o[e] = g[e] * (p.wa_conv[c8 + e] * p2[e] + p.wa_conv[1024 + c8 + e] * p1[e] + p.wa_conv[2048 + c8 + e] * cur[e]);
    u32x4 ov; ov[0] = pk2(o[0], o[1]); ov[1] = pk2(o[2], o[3]); ov[2] = pk2(o[4], o[5]); ov[3] = pk2(o[6], o[7]);
    *(u32x4*)(AB + (size_t)row * 1024 + c8) = ov;
  }
}

template <int FINAL>
DI void ln_phase(const Params& p) {
  const int tid0 = otid();
  const int lane = tid0 & 63;
  const int gw = blockIdx.x * 4 + (tid0 >> 6), nw = gridDim.x * 4;
  const float* MOD1 = (const float*)(p.ws + WS_MOD) + (size_t)136 * 3072;
  float* ST = (float*)(p.ws + WS_STATS);
  bf16_t* AB = (bf16_t*)(p.ws + WS_ABUF);
  const float* lg = p.ln_g + (FINAL ? 1024 : 0); const float* lb = p.ln_b + (FINAL ? 1024 : 0);
  for (int row = gw; row < MTOT; row += nw) {
    float* yr = p.out + OUT_Y + (size_t)row * 1024;
    f32x4 v[4];
    float s = 0.f;
#pragma unroll
    for (int j = 0; j < 4; ++j) { v[j] = FINAL ? __builtin_nontemporal_load((const f32x4*)(yr + j * 256 + lane * 4)) : *(const f32x4*)(yr + j * 256 + lane * 4); s += v[j][0] + v[j][1] + v[j][2] + v[j][3]; }
#pragma unroll
    for (int o = 32; o >= 1; o >>= 1) s += __shfl_xor(s, o);
    const float mu = s * (1.f / 1024.f);
    float q = 0.f;
#pragma unroll
    for (int j = 0; j < 4; ++j)
#pragma unroll
      for (int e = 0; e < 4; ++e) { const float d = v[j][e] - mu; q += d * d; }
#pragma unroll
    for (int o = 32; o >= 1; o >>= 1) q += __shfl_xor(q, o);
    const float rstd = rsqrtf(q * (1.f / 1024.f) + 1e-5f);
    if (!FINAL && lane == 0) { ST[row * 2] = mu; ST[row * 2 + 1] = rstd; }
    const float* md = MOD1 + (size_t)bidx(row) * 3072;
#pragma unroll
    for (int j = 0; j < 4; ++j) {
      const int col = j * 256 + lane * 4;
      const f32x4 g4 = *(const f32x4*)(lg + col), b4 = *(const f32x4*)(lb + col);
      f32x4 x1;
#pragma unroll
      for (int e = 0; e < 4; ++e) x1[e] = (v[j][e] - mu) * rstd * g4[e] + b4[e];
      if (FINAL) { __builtin_nontemporal_store(x1, (f32x4*)(yr + col)); }
      else {
        const f32x4 sh = *(const f32x4*)(md + col), sc = *(const f32x4*)(md + 1024 + col);
        u32x2 o; o[0] = pk2(x1[0] * (1.f + sc[0]) + sh[0], x1[1] * (1.f + sc[1]) + sh[1]); o[1] = pk2(x1[2] * (1.f + sc[2]) + sh[2], x1[3] * (1.f + sc[3]) + sh[3]);
        *(u32x2*)(AB + (size_t)row * 1024 + col) = o;
      }
    }
  }
}

DI void gdn_chunk_local(const Params& p, char* smem0) {
  for (int task = blockIdx.x; task < 2048; task += gridDim.x) {
  int tid = threadIdx.x; asm volatile("" : "+v"(tid));
  int off0 = 0; asm volatile("" : "+v"(off0));
  char* smem = (char*)__builtin_assume_aligned(smem0 + (off0 & ~15), 16);
  const int lane = tid & 63, wave = __builtin_amdgcn_readfirstlane(tid >> 6);
  bf16_t* sq = (bf16_t*)smem;
  bf16_t* sk = sq + 64 * 136;
  bf16_t* sv = sk + 64 * 136;
  float* sAm = (float*)(smem + 3 * 17408);
  float* sc = (float*)(smem + 4 * 17408);
  float *sG = sc, *sBeta = sc + 64, *sRq = sc + 128, *sRk = sc + 192, *sSsq = sc + 256, *sSsk = sc + 320, *sBk = sc + 384, *sEg = sc + 448, *sKt = sc + 512;
  const bf16_t* QKV = (const bf16_t*)(p.ws + WS_QKV);
  const float* BA = (const float*)(p.ws + WS_BA);
  float* GL = (float*)(p.ws + WS_GL);
  bf16_t* Ug = (bf16_t*)(p.ws + WS_U); bf16_t* Wg = (bf16_t*)(p.ws + WS_W); bf16_t* ATT = (bf16_t*)(p.ws + WS_ATTN);
  bf16_t* QG = (bf16_t*)(p.out + OUT_SSS); bf16_t* KT = QG + (size_t)2048 * 8192;
  {
    const int n = task & 31, h = (task >> 5) & 7, b = task >> 8;
    const int row0 = b * 2048 + n * 64;
    {
      const int cg16 = tid & 15, rsub = tid >> 4;
      u32x4 raw[3][7];
#pragma unroll
      for (int seg = 0; seg < 3; ++seg)
#pragma unroll
        for (int r7 = 0; r7 < 7; ++r7) {
          const int ii = rsub * 4 - 3 + r7;
          if (n * 64 + ii >= 0) raw[seg][r7] = __builtin_nontemporal_load((const u32x4*)(QKV + (size_t)(row0 + ii) * 3072 + seg * 1024 + h * 128 + cg16 * 8));
          else { raw[seg][r7][0] = 0u; raw[seg][r7][1] = 0u; raw[seg][r7][2] = 0u; raw[seg][r7][3] = 0u; }
        }
#pragma unroll
      for (int seg = 0; seg < 3; ++seg) {
        const int colbase = seg * 1024 + h * 128 + cg16 * 8;
        float wt[4][8];
#pragma unroll
        for (int j = 0; j < 4; ++j) {
          const f32x4 w0 = *(const f32x4*)(p.wb_conv + j * 3072 + colbase), w1 = *(const f32x4*)(p.wb_conv + j * 3072 + colbase + 4);
#pragma unroll
          for (int e = 0; e < 4; ++e) { wt[j][e] = w0[e]; wt[j][4 + e] = w1[e]; }
        }
        bf16_t* dst = sq + seg * (64 * 136);
#pragma unroll
        for (int o4 = 0; o4 < 4; ++o4) {
          const int i = rsub * 4 + o4;
          float a8[8];
#pragma unroll
          for (int e = 0; e < 8; ++e) a8[e] = 0.f;
#pragma unroll
          for (int j = 0; j < 4; ++j) {
#pragma unroll
            for (int e = 0; e < 4; ++e) { a8[2 * e] += wt[j][2 * e] * bflo(raw[seg][o4 + j][e]); a8[2 * e + 1] += wt[j][2 * e + 1] * bfhi(raw[seg][o4 + j][e]); }
          }
          float ss = 0.f;
#pragma unroll
          for (int e = 0; e < 8; ++e) { a8[e] = silu(a8[e]); ss += a8[e] * a8[e]; }
          u32x4 o; o[0] = pk2(a8[0], a8[1]); o[1] = pk2(a8[2], a8[3]); o[2] = pk2(a8[4], a8[5]); o[3] = pk2(a8[6], a8[7]);
          *(u32x4*)(dst + i * 136 + cg16 * 8) = o;
          if (seg < 2) {
#pragma unroll
            for (int o2 = 8; o2 >= 1; o2 >>= 1) ss += __shfl_xor(ss, o2);
            if (cg16 == 0) sSsq[seg * 64 + i] = ss;
          }
        }
      }
    }
    __syncthreads();
    if (tid < 64) {
      const int row = row0 + tid;
      const float bb = BA[(size_t)row * 16 + h], aa = BA[(size_t)row * 16 + 8 + h];
      const float beta = 1.f / (1.f + expf(-bb));
      const float xx = aa + p.wb_dt_bias[h];
      const float sp = xx > 20.f ? xx : log1pf(expf(xx));
      const float g = -expf(p.wb_a_log[h]) * sp;
      float G = g;
#pragma unroll
      for (int off = 1; off < 64; off <<= 1) { const float tv = __shfl_up(G, off); if (lane >= off) G += tv; }
      const float Gl = __shfl(G, 63);
      const float rk = rsqrtf(sSsk[tid] + 1e-6f), rq = rsqrtf(sSsq[tid] + 1e-6f) * 0.08838834764831845f;
      const float eg = expf(G);
      sG[tid] = G; sBeta[tid] = beta; sRq[tid] = rq * eg; sRk[tid] = rk; sBk[tid] = rk * beta * eg; sEg[tid] = rq; sKt[tid] = rk * expf(Gl - G);
      if (tid == 63) GL[task] = eg;
    }
    __syncthreads();
    {
      bf16_t* qgo = QG + (size_t)task * 8192; bf16_t* kto = KT + (size_t)task * 8192;
#pragma unroll
      for (int c4 = 0; c4 < 4; ++c4) {
        const int o = tid + 256 * c4;
        {
          const int mt = o >> 9, s = (o >> 6) & 7, ln = o & 63, i = mt * 32 + (ln & 31), hh = ln >> 5;
          const u32x2 lo = *(const u32x2*)(sq + i * 136 + s * 16 + hh * 4), hi = *(const u32x2*)(sq + i * 136 + s * 16 + 8 + hh * 4);
          const float f = sRq[i];
          u32x4 ov; ov[0] = pk2(bflo(lo[0]) * f, bfhi(lo[0]) * f); ov[1] = pk2(bflo(lo[1]) * f, bfhi(lo[1]) * f);
          ov[2] = pk2(bflo(hi[0]) * f, bfhi(hi[0]) * f); ov[3] = pk2(bflo(hi[1]) * f, bfhi(hi[1]) * f);
          *(u32x4*)(qgo + (size_t)o * 8) = ov;
        }
        {
          const int mt = o >> 8, s = (o >> 6) & 3, ln = o & 63, m = mt * 32 + (ln & 31), hh = ln >> 5;
          float vv[8];
#pragma unroll
          for (int e = 0; e < 8; ++e) { const int j = s * 16 + (e >> 2) * 8 + hh * 4 + (e & 3); vv[e] = bf2f(sk[j * 136 + m]) * sKt[j]; }
          u32x4 ov; ov[0] = pk2(vv[0], vv[1]); ov[1] = pk2(vv[2], vv[3]); ov[2] = pk2(vv[4], vv[5]); ov[3] = pk2(vv[6], vv[7]);
          *(u32x4*)(kto + (size_t)o * 8) = ov;
        }
      }
    }
    const int mat = wave >> 1, gmi = wave & 1;
    f32x16 g2[2];
#pragma unroll
    for (int nj = 0; nj < 2; ++nj)
#pragma unroll
      for (int i = 0; i < 16; ++i) g2[nj][i] = 0.f;
    {
      const bf16_t* srcA = mat ? sq : sk;
#pragma unroll
      for (int ks = 0; ks < 8; ++ks) {
        const bf16x8 a = *(const bf16x8*)(srcA + (gmi * 32 + (lane & 31)) * 136 + ks * 16 + (lane >> 5) * 8);
#pragma unroll
        for (int nj = 0; nj < 2; ++nj) {
          const bf16x8 bb = *(const bf16x8*)(sk + (nj * 32 + (lane & 31)) * 136 + ks * 16 + (lane >> 5) * 8);
          g2[nj] = MFMA32(a, bb, g2[nj]);
        }
      }
    }
    __syncthreads();
#pragma unroll
    for (int nj = 0; nj < 2; ++nj)
#pragma unroll
      for (int r = 0; r < 16; ++r) {
        const int i = gmi * 32 + rowi(r, lane), j = nj * 32 + (lane & 31);
        const float dec = __expf(fminf(sG[i] - sG[j], 0.f));
        if (mat == 0) {
          sAm[i * 68 + j] = (i > j) ? sBeta[i] * sRk[i] * sRk[j] * dec * g2[nj][r] : 0.f;
        } else {
          const float val = (i >= j) ? sEg[i] * sRk[j] * dec * g2[nj][r] : 0.f;
          const int s = j >> 4, q = j & 15, e = (q >> 3) * 4 + (q & 3), hh = (q >> 2) & 1, ln = (i & 31) + 32 * hh;
          sq[((gmi * 4 + s) * 64 + ln) * 8 + e] = (bf16_t)f2bf(val);
        }
      }
    __syncthreads();
#pragma unroll
    for (int c = 0; c < 2; ++c) { const int o = tid + 256 * c; *(u32x4*)(ATT + (size_t)task * 4096 + (size_t)o * 8) = *(const u32x4*)(sq + o * 8); }
    typedef float f32x2 __attribute__((ext_vector_type(2)));
    f32x2 xv[32];
    {
      const bool isV = tid < 128;
      const bf16_t* src = isV ? (sv + tid) : (sk + (tid - 128));
      const float* scl = isV ? sBeta : sBk;
#pragma unroll
      for (int i = 0; i < 64; ++i) {
        f32x2 r0 = {bf2f(src[i * 136]) * scl[i], 0.f}, r1 = {0.f, 0.f};
#pragma unroll
        for (int m = 0; m < i / 2; ++m) {
          const f32x2 a2 = *(const f32x2*)(sAm + i * 68 + 2 * m);
          if (m & 1) r1 -= a2 * xv[m]; else r0 -= a2 * xv[m];
        }
        r0 += r1;
        float r = r0[0] + r0[1];
        if (i & 1) r -= sAm[i * 68 + i - 1] * xv[i / 2][0];
        xv[i / 2][i & 1] = r;
      }
    }
#define XS(i) xv[(i) >> 1][(i) & 1]
    __syncthreads();
    if (tid < 128) {
      const int s = tid >> 5, nn = tid & 31;
#pragma unroll
      for (int i = 0; i < 64; ++i) {
        const int mt = i >> 5, ii = i & 31, hh = (ii >> 2) & 1, r = (ii >> 3) * 4 + (ii & 3);
        sv[((s * 2 + mt) * 64 + nn + 32 * hh) * 16 + r] = (bf16_t)f2bf(XS(i));
      }
    } else {
      const int c = tid - 128, s = c >> 4, q = c & 15, e = (q >> 3) * 4 + (q & 3), hh = (q >> 2) & 1;
#pragma unroll
      for (int i = 0; i < 64; ++i) {
        const int mt = i >> 5;
        sk[((mt * 8 + s) * 64 + (i & 31) + 32 * hh) * 8 + e] = (bf16_t)f2bf(XS(i));
      }
    }
    __syncthreads();
#pragma unroll
    for (int c = 0; c < 4; ++c) {
      const int o = tid + 256 * c;
      *(u32x4*)(Ug + (size_t)task * 8192 + (size_t)o * 8) = *(const u32x4*)(sv + o * 8);
      *(u32x4*)(Wg + (size_t)task * 8192 + (size_t)o * 8) = *(const u32x4*)(sk + o * 8);
    }
    __syncthreads();
  }
  }
}

DI void gdn_scan(const Params& p, char* smem) {
  if (blockIdx.x >= 256) return;
  const int tid = otid(), lane = tid & 63, wave = __builtin_amdgcn_readfirstlane(tid >> 6);
  const int xcd = blockIdx.x & 7, yy = blockIdx.x >> 3;
  const int bh = xcd * 8 + (yy >> 2), s = yy & 3, h = bh & 7, b = bh >> 3;
  bf16x8* Sfrag = (bf16x8*)smem;
  bf16x8* Vfrag = Sfrag + 512;
  const bf16_t* Ug = (const bf16_t*)(p.ws + WS_U); const bf16_t* Wg = (const bf16_t*)(p.ws + WS_W); const bf16_t* ATT = (const bf16_t*)(p.ws + WS_ATTN);
  const bf16_t* QG = (const bf16_t*)(p.out + OUT_SSS); const bf16_t* KT = QG + (size_t)2048 * 8192;
  const float* GL = (const float*)(p.ws + WS_GL);
  bf16_t* O = (bf16_t*)(p.ws + WS_O);
  const size_t cbase = (size_t)(b * 8 + h) * 32;
  const bool isW = wave < 2; const int mi = wave & 1;
  f32x16 S;
#pragma unroll
  for (int i = 0; i < 16; ++i) S[i] = 0.f;
  { bf16x8 z; for (int e = 0; e < 8; ++e) z[e] = 0; for (int o = tid; o < 512; o += 256) Sfrag[o] = z; }
  const bf16_t* aBase = (isW ? Wg : QG) + cbase * 8192 + (size_t)(mi * 8) * 512 + lane * 8;
  const bf16_t* kBase = KT + cbase * 8192 + (size_t)(wave * 4) * 512 + lane * 8;
  const bf16_t* tBase = ATT + cbase * 4096 + (size_t)(mi * 4) * 512 + lane * 8;
  const bf16_t* uBase = Ug + cbase * 8192 + (size_t)((s * 2 + mi) * 64 + lane) * 16;
  struct Regs { bf16x8 afr[8], kfr[4], tfr[4]; u32x4 ur[2]; };
  const float glv = GL[cbase + (lane & 31)];
  Regs R0, R1;
  auto load_all = [&](Regs& R, int n) {
#pragma unroll
    for (int ks = 0; ks < 8; ++ks) R.afr[ks] = *(const bf16x8*)(aBase + (size_t)n * 8192 + ks * 512);
#pragma unroll
    for (int k4 = 0; k4 < 4; ++k4) { R.kfr[k4] = *(const bf16x8*)(kBase + (size_t)n * 8192 + k4 * 512); R.tfr[k4] = *(const bf16x8*)(tBase + (size_t)n * 4096 + k4 * 512); }
    R.ur[0] = __builtin_nontemporal_load((const u32x4*)(uBase + (size_t)n * 8192)); R.ur[1] = __builtin_nontemporal_load((const u32x4*)(uBase + (size_t)n * 8192 + 8));
  };
  load_all(R0, 0);
  load_all(R1, 1);
  __syncthreads();
  auto step = [&](Regs& R, const int n) {
    const int nn = n + 2 < 32 ? n + 2 : 31;
    f32x16 acc0, acc1;
#pragma unroll
    for (int i = 0; i < 16; ++i) { acc0[i] = 0.f; acc1[i] = 0.f; }
#pragma unroll
    for (int ks = 0; ks < 8; ks += 2) {
      acc0 = MFMA32(R.afr[ks], Sfrag[ks * 64 + lane], acc0);
      acc1 = MFMA32(R.afr[ks + 1], Sfrag[(ks + 1) * 64 + lane], acc1);
    }
#pragma unroll
    for (int i = 0; i < 16; ++i) acc0[i] += acc1[i];
#pragma unroll
    for (int ks = 0; ks < 8; ++ks) R.afr[ks] = *(const bf16x8*)(aBase + (size_t)nn * 8192 + ks * 512);
    if (isW) {
      f32x16 vn;
#pragma unroll
      for (int e = 0; e < 4; ++e) {
        vn[2 * e] = bflo(R.ur[0][e]) - acc0[2 * e]; vn[2 * e + 1] = bfhi(R.ur[0][e]) - acc0[2 * e + 1];
        vn[8 + 2 * e] = bflo(R.ur[1][e]) - acc0[8 + 2 * e]; vn[8 + 2 * e + 1] = bfhi(R.ur[1][e]) - acc0[8 + 2 * e + 1];
      }
      Vfrag[(2 * mi) * 64 + lane] = pack8(vn, 0);
      Vfrag[(2 * mi + 1) * 64 + lane] = pack8(vn, 1);
      R.ur[0] = __builtin_nontemporal_load((const u32x4*)(uBase + (size_t)nn * 8192)); R.ur[1] = __builtin_nontemporal_load((const u32x4*)(uBase + (size_t)nn * 8192 + 8));
    }
    lds_barrier();
    if (!isW) {
#pragma unroll
      for (int k4 = 0; k4 < 4; ++k4) acc0 = MFMA32(R.tfr[k4], Vfrag[k4 * 64 + lane], acc0);
      bf16_t* op = O + (size_t)(b * 2048 + n * 64 + mi * 32) * 1024 + h * 128 + s * 32 + (lane & 30);
#pragma unroll
      for (int ip = 0; ip < 8; ++ip) *(unsigned*)(op + (size_t)rowi(2 * ip + (lane & 1), lane) * 1024) = pair_pk(acc0[2 * ip], acc0[2 * ip + 1], lane);
#pragma unroll
      for (int k4 = 0; k4 < 4; ++k4) R.tfr[k4] = *(const bf16x8*)(tBase + (size_t)nn * 4096 + k4 * 512);
    }
    const float gl = __builtin_bit_cast(float, __builtin_amdgcn_readlane(__builtin_bit_cast(int, glv), n));
#pragma unroll
    for (int i = 0; i < 16; ++i) S[i] *= gl;
#pragma unroll
    for (int k4 = 0; k4 < 4; ++k4) S = MFMA32(R.kfr[k4], Vfrag[k4 * 64 + lane], S);
#pragma unroll
    for (int k4 = 0; k4 < 4; ++k4) R.kfr[k4] = *(const bf16x8*)(kBase + (size_t)nn * 8192 + k4 * 512);
    Sfrag[(2 * wave) * 64 + lane] = pack8(S, 0);
    Sfrag[(2 * wave + 1) * 64 + lane] = pack8(S, 1);
    lds_barrier();
  };
#pragma unroll 1
  for (int n = 0; n < 32; n += 2) { step(R0, n); step(R1, n + 1); }
  float* so = p.out + OUT_SSP + ((size_t)(b * 8 + h) * 128 + wave * 32) * 128 + s * 32 + (lane & 31);
#pragma unroll
  for (int r = 0; r < 16; ++r) so[(size_t)rowi(r, lane) * 128] = S[r];
}

DI void sample_task(const Params& p, char* smem, int task) {
  const int tid = otid(), lane = tid & 63, wave = tid >> 6;
  const int bs = task >> 3, h = task & 7;
  float* fq = (float*)smem; float* fk = fq + 1024; float* fv = fk + 1024; float* red = fv + 1024; float* ored = red + 2048; float* scal = ored + 2048;
  const bf16_t* QKV = (const bf16_t*)(p.ws + WS_QKV); const float* BA = (const float*)(p.ws + WS_BA);
  const bf16_t* Z = (const bf16_t*)(p.ws + WS_Z); bf16_t* AB = (bf16_t*)(p.ws + WS_ABUF);
  const int rowb = MP + bs * 8;
#pragma unroll
  for (int it = 0; it < 12; ++it) {
    const int idx = tid + 256 * it;
    const int tok = idx / 384, cc = idx - tok * 384, seg = cc >> 7, c = cc & 127, col = seg * 1024 + h * 128 + c;
    float acc = 0.f;
#pragma unroll
    for (int j = 0; j < 4; ++j) {
      const int tt = tok + j;
      const float xs = p.st_conv_b[((size_t)bs * 3 + (tt < 3 ? tt : 2)) * 3072 + col];
      const float xq = bf2f(QKV[(size_t)(rowb + (tt >= 3 ? tt - 3 : 0)) * 3072 + col]);
      acc += p.wb_conv[j * 3072 + col] * (tt < 3 ? xs : xq);
    }
    (seg == 0 ? fq : (seg == 1 ? fk : fv))[tok * 128 + c] = silu(acc);
  }
  if (tid < 8) {
    const int row = rowb + tid;
    const float bb = BA[(size_t)row * 16 + h], aa = BA[(size_t)row * 16 + 8 + h];
    const float xx = aa + p.wb_dt_bias[h];
    const float sp = xx > 20.f ? xx : log1pf(expf(xx));
    scal[tid] = 1.f / (1.f + expf(-bb));
    scal[8 + tid] = expf(-expf(p.wb_a_log[h]) * sp);
  }
  __syncthreads();
#pragma unroll
  for (int rr = 0; rr < 4; ++rr) {
    const int r16 = wave * 4 + rr;
    float* ptr = r16 < 8 ? fq + r16 * 128 : fk + (r16 - 8) * 128;
    const float a0 = ptr[lane], a1 = ptr[lane + 64];
    float ss = a0 * a0 + a1 * a1;
#pragma unroll
    for (int o = 32; o >= 1; o >>= 1) ss += __shfl_xor(ss, o);
    const float f = rsqrtf(ss + 1e-6f) * (r16 < 8 ? 0.08838834764831845f : 1.f);
    ptr[lane] = a0 * f; ptr[lane + 64] = a1 * f;
  }
  __syncthreads();
  const int vcol = tid & 127, kh = tid >> 7;
  float S[64];
  {
    const float* sp = p.st_ssm + (((size_t)bs * 8 + h) * 128 + kh * 64) * 128 + vcol;
#pragma unroll
    for (int kk = 0; kk < 64; ++kk) S[kk] = __builtin_nontemporal_load(sp + (size_t)kk * 128);
  }
#pragma unroll 1
  for (int t = 0; t < 8; ++t) {
    const float* kt = fk + t * 128 + kh * 64;
    const float* qt = fq + t * 128 + kh * 64;
    float part = 0.f;
#pragma unroll
    for (int kk = 0; kk < 64; ++kk) part += kt[kk] * S[kk];
    red[(t * 2 + kh) * 128 + vcol] = part;
    __syncthreads();
    const float kS = red[(t * 2) * 128 + vcol] + red[(t * 2 + 1) * 128 + vcol];
    const float a = scal[8 + t], be = scal[t];
    const float d = be * (fv[t * 128 + vcol] - a * kS);
    float op = 0.f;
#pragma unroll
    for (int kk = 0; kk < 64; ++kk) { S[kk] = a * S[kk] + kt[kk] * d; op += qt[kk] * S[kk]; }
    ored[(t * 2 + kh) * 128 + vcol] = op;
  }
  {
    float* so = p.out + OUT_SSS + (((size_t)bs * 8 + h) * 128 + kh * 64) * 128 + vcol;
#pragma unroll
    for (int kk = 0; kk < 64; ++kk) __builtin_nontemporal_store(S[kk], so + (size_t)kk * 128);
  }
  __syncthreads();
  {
    const int tok = tid >> 5, c4 = (tid & 31) * 4;
    float o[4]; float ss = 0.f;
#pragma unroll
    for (int e = 0; e < 4; ++e) { o[e] = ored[(tok * 2) * 128 + c4 + e] + ored[(tok * 2 + 1) * 128 + c4 + e]; ss += o[e] * o[e]; }
#pragma unroll
    for (int o2 = 16; o2 >= 1; o2 >>= 1) ss += __shfl_xor(ss, o2);
    const float rstd = rsqrtf(ss * (1.f / 128.f) + 1e-6f);
    const u32x2 zr = *(const u32x2*)(Z + (size_t)(rowb + tok) * 1024 + h * 128 + c4);
    const float z0 = bflo(zr[0]), z1 = bfhi(zr[0]), z2 = bflo(zr[1]), z3 = bfhi(zr[1]);
    u32x2 ov;
    ov[0] = pk2(o[0] * rstd * p.wb_norm[c4] * silu(z0), o[1] * rstd * p.wb_norm[c4 + 1] * silu(z1));
    ov[1] = pk2(o[2] * rstd * p.wb_norm[c4 + 2] * silu(z2), o[3] * rstd * p.wb_norm[c4 + 3] * silu(z3));
    *(u32x2*)(AB + (size_t)(rowb + tok) * 1024 + h * 128 + c4) = ov;
  }
  __syncthreads();
}

DI void phase9(const Params& p, char* smem) {
  const int tid9 = otid();
  const int lane = tid9 & 63, wave = tid9 >> 6;
  const bf16_t* O = (const bf16_t*)(p.ws + WS_O); const bf16_t* Z = (const bf16_t*)(p.ws + WS_Z); bf16_t* AB = (bf16_t*)(p.ws + WS_ABUF);
  for (int task = blockIdx.x; task < 2048; task += gridDim.x) {
    if (task < 1024) { sample_task(p, smem, task); continue; }
    const int r0 = (task - 1024) * 16 + wave * 4;
#pragma unroll
    for (int rr = 0; rr < 4; ++rr) {
      const int row = r0 + rr;
#pragma unroll
      for (int j = 0; j < 4; ++j) {
        const int col = j * 256 + lane * 4;
        const u32x2 orw = __builtin_nontemporal_load((const u32x2*)(O + (size_t)row * 1024 + col));
        f32x4 o4; o4[0] = bflo(orw[0]); o4[1] = bfhi(orw[0]); o4[2] = bflo(orw[1]); o4[3] = bfhi(orw[1]);
        float ss = o4[0] * o4[0] + o4[1] * o4[1] + o4[2] * o4[2] + o4[3] * o4[3];
#pragma unroll
        for (int o2 = 16; o2 >= 1; o2 >>= 1) ss += __shfl_xor(ss, o2);
        const float rstd = rsqrtf(ss * (1.f / 128.f) + 1e-6f);
        const u32x2 zr = __builtin_nontemporal_load((const u32x2*)(Z + (size_t)row * 1024 + col));
        const f32x4 nw = *(const f32x4*)(p.wb_norm + (col & 127));
        u32x2 ov;
        ov[0] = pk2(o4[0] * rstd * nw[0] * silu(bflo(zr[0])), o4[1] * rstd * nw[1] * silu(bfhi(zr[0])));
        ov[1] = pk2(o4[2] * rstd * nw[2] * silu(bflo(zr[1])), o4[3] * rstd * nw[3] * silu(bfhi(zr[1])));
        *(u32x2*)(AB + (size_t)row * 1024 + col) = ov;
      }
    }
  }
}

__global__ void __launch_bounds__(256, 2) fwd_megakernel(Params p) {
  extern __shared__ __attribute__((aligned(16))) char smem[];
  cg::grid_group grid = cg::this_grid();
  if (p.out == nullptr) grid.sync();
  __shared__ uint4 xb_words;
  if (threadIdx.x == 0) xb_words = make_uint4(0u, 0u, 0u, 0u);
  __syncthreads();
  XcdBarrier xb = xcd_barrier_post((unsigned*)(p.ws + WS_BAR), (volatile LAS unsigned*)&xb_words);
#define GSYNC() xcd_barrier(xb)
  phase0a(p);
  GSYNC();
  phase0(p, smem);
  GSYNC();
  phase1(p);
  GSYNC();
  { Epi1<4> e{(bf16_t*)(p.ws + WS_CH), (bf16_t*)(p.ws + WS_G1), p.out}; gemm_phase<4>((const bf16_t*)(p.ws + WS_ABUF), (const bf16_t*)(p.ws + WS_WT1), 32, smem, e); }
  GSYNC();
  phase3(p);
  GSYNC();
  { Epi2<2> e{p}; gemm_phase<2>((const bf16_t*)(p.ws + WS_ABUF), (const bf16_t*)(p.ws + WS_WT2), 8, smem, e); }
  GSYNC();
  ln_phase<0>(p);
  GSYNC();
  { Epi3<4> e{p}; gemm_phase<4>((const bf16_t*)(p.ws + WS_ABUF), (const bf16_t*)(p.ws + WS_WT3), 33, smem, e); }
  GSYNC();
  gdn_chunk_local(p, smem);
  GSYNC();
  gdn_scan(p, smem);
  GSYNC();
  phase9(p, smem);
  GSYNC();
  { Epi4<2> e{p}; gemm_phase<2>((const bf16_t*)(p.ws + WS_ABUF), (const bf16_t*)(p.ws + WS_WT4), 8, smem, e); }
  GSYNC();
  ln_phase<1>(p);
}

extern "C" void kernel_launch(void* const* d_in, const int* in_sizes, int n_in, void* d_out, int out_size, void* d_ws, size_t ws_size, hipStream_t stream) {
  static int grid_blocks = 0;
  if (!grid_blocks) {
    int dev = 0, cus = 0, per_cu = 0;
    hipGetDevice(&dev);
    hipDeviceGetAttribute(&cus, hipDeviceAttributeMultiprocessorCount, dev);
    hipFuncSetAttribute((const void*)fwd_megakernel, hipFuncAttributeMaxDynamicSharedMemorySize, LDS_BYTES);
    hipOccupancyMaxActiveBlocksPerMultiprocessor(&per_cu, (const void*)fwd_megakernel, 256, LDS_BYTES);
    if (per_cu < 1) per_cu = 1;
    if (per_cu > 2) per_cu = 2;
    grid_blocks = cus * per_cu;
    if (ws_size < 247 * MiB) fprintf(stderr, "kernel_launch: workspace too small: %zu\n", ws_size);
  }
  Params p{};
  const float** pp = (const float**)&p;
  for (int i = 0; i < 20; ++i) pp[i] = (const float*)d_in[i];
  p.out = (float*)d_out; p.ws = (char*)d_ws;
  hipMemsetAsync((char*)d_ws + WS_BAR, 0, XCD_BAR_WORDS * 4, stream);
  void* args[] = {&p};
  hipError_t e = hipLaunchCooperativeKernel((const void*)fwd_megakernel, dim3(grid_blocks), dim3(256), args, LDS_BYTES, stream);
  if (e != hipSuccess) fprintf(stderr, "cooperative launch failed: %s (grid %d)\n", hipGetErrorString(e), grid_blocks);
}
```

```cpp
#include <hip/hip_runtime.h>
#include <hip/hip_cooperative_groups.h>
#include <cstdio>
namespace cg = cooperative_groups;

typedef unsigned short bf16_t;
typedef short bf16x8 __attribute__((ext_vector_type(8)));
typedef float f32x16 __attribute__((ext_vector_type(16)));
typedef float f32x4 __attribute__((ext_vector_type(4)));
typedef unsigned u32x4 __attribute__((ext_vector_type(4)));
typedef unsigned u32x2 __attribute__((ext_vector_type(2)));

#define DI __device__ __forceinline__
#define MFMA32(a, b, c) __builtin_amdgcn_mfma_f32_32x32x16_bf16((a), (b), (c), 0, 0, 0)

constexpr int MTOT = 17408, MP = 16384;
constexpr size_t MiB = 1ull << 20;
constexpr size_t WS_WT1 = 0, WS_WT2 = 8 * MiB, WS_WT3 = 10 * MiB, WS_WT4 = 19 * MiB, WS_MOD = 21 * MiB, WS_STATS = 25 * MiB,
                 WS_BA = 25 * MiB + 512 * 1024, WS_GL = 26 * MiB + 768 * 1024, WS_BAR = 26 * MiB + 832 * 1024, WS_CST = 24 * MiB + 256 * 1024, WS_ABUF = 27 * MiB, WS_CH = 61 * MiB, WS_G1 = 95 * MiB,
                 WS_QKV = 129 * MiB, WS_ATTN = 231 * MiB;
constexpr size_t WS_U = WS_ABUF, WS_Z = WS_CH, WS_W = WS_G1, WS_O = WS_QKV;
constexpr size_t OUT_Y = 0, OUT_CAP = 17825792, OUT_CBP = 17842176, OUT_SSP = 17915904, OUT_CAS = 18964480, OUT_CBS = 19226624, OUT_SSS = 20406272;
constexpr int LDS_BYTES = 72192;
constexpr float ALPHA_F = 1.41421356237309515f;

struct Params {
  const float *x_p, *x_s, *st_conv_a, *st_conv_b, *st_ssm, *c_p, *c_s, *w_mod, *b_mod, *ln_g, *ln_b, *wa_in, *wa_conv, *wa_out, *wb_in, *wb_conv,
      *wb_a_log, *wb_dt_bias, *wb_norm, *wb_out;
  float* out;
  char* ws;
};

typedef float f32x2v __attribute__((ext_vector_type(2)));
typedef __bf16 bf16x2v __attribute__((ext_vector_type(2)));
DI unsigned pk2(float lo, float hi) { f32x2v v = {lo, hi}; bf16x2v b = __builtin_convertvector(v, bf16x2v); return __builtin_bit_cast(unsigned, b); }
DI unsigned f2bf(float x) { __bf16 b = (__bf16)x; return (unsigned)__builtin_bit_cast(unsigned short, b); }
DI float bflo(unsigned u) { return __uint_as_float(u << 16); }
DI float bfhi(unsigned u) { return __uint_as_float(u & 0xffff0000u); }
DI float bf2f(bf16_t v) { return __uint_as_float(((unsigned)v) << 16); }
DI float silu(float x) { return x * __builtin_amdgcn_rcpf(1.f + __expf(-x)); }
DI int otid() { int t = threadIdx.x; asm volatile("" : "+v"(t)); return t; }
DI int rowi(int i, int lane) { return (i & 3) + 8 * (i >> 2) + 4 * (lane >> 5); }
DI int bidx(int row) { return row < MP ? (row >> 11) : 8 + ((row - MP) >> 3); }
DI const float* xrow(const Params& p, int row) { return row < MP ? p.x_p + (size_t)row * 1024 : p.x_s + (size_t)(row - MP) * 1024; }
DI bf16x8 pack8(const f32x16& x, int s) {
  u32x4 r;
  r[0] = pk2(x[8 * s + 0], x[8 * s + 1]); r[1] = pk2(x[8 * s + 2], x[8 * s + 3]); r[2] = pk2(x[8 * s + 4], x[8 * s + 5]); r[3] = pk2(x[8 * s + 6], x[8 * s + 7]);
  return __builtin_bit_cast(bf16x8, r);
}


#define XB_TMO      128
#define XB_XCNT(j)  (256  + 64 * (j))
#define XB_XSUB(j)  (1280 + 64 * (j))
#define XB_XGEN(j)  (2304 + 64 * (j))
#define XB_TOP      3328
#define XB_TOPGEN   3392
#define XCD_BAR_WORDS 3456
#define XB_SPIN_CAP (1u << 18)
#define LAS __attribute__((address_space(3)))
DI unsigned xb_ld(unsigned* p) { return __hip_atomic_load(p, __ATOMIC_RELAXED, __HIP_MEMORY_SCOPE_AGENT); }
DI unsigned xb_add(unsigned* p, unsigned v) { return __hip_atomic_fetch_add(p, v, __ATOMIC_RELAXED, __HIP_MEMORY_SCOPE_AGENT); }
DI unsigned xb_xcc_id() { return (unsigned)__builtin_amdgcn_s_getreg((3 << 11) | 20) & 0xFu; }
#define XB_SPIN(cond, bar) do { unsigned _sp = 0; while (cond) { __builtin_amdgcn_s_sleep(1); \
    if ((++_sp & 255u) == 0u) { if (xb_ld(&(bar)[XB_TMO])) break; if (_sp > XB_SPIN_CAP) { atomicAdd(&(bar)[XB_TMO], 1u); break; } } } } while (0)
struct XcdBarrier { unsigned* bar; unsigned x; volatile LAS unsigned* st; };
DI XcdBarrier xcd_barrier_post(unsigned* bar, volatile LAS unsigned* st) {
  XcdBarrier b; b.bar = bar; b.x = xb_xcc_id(); b.st = st;
  if (threadIdx.x == 0) (void)xb_add(&bar[XB_XCNT(b.x)], 1u);
  return b;
}
DI void xcd_barrier_complete(unsigned* bar, unsigned x, unsigned& nloc, unsigned& nx) {
  const unsigned G = gridDim.x * gridDim.y * gridDim.z;
  unsigned sum, cnt, mine, sp = 0u;
  for (;;) {
    sum = 0u; cnt = 0u; mine = 0u;
#pragma unroll
    for (unsigned j = 0; j < 16; ++j) { const unsigned c = xb_ld(&bar[XB_XCNT(j)]); sum += c; cnt += (c > 0u) ? 1u : 0u; mine = (j == x) ? c : mine; }
    if (sum == G) break;
    __builtin_amdgcn_s_sleep(1);
    if ((++sp & 255u) == 0u) { if (xb_ld(&bar[XB_TMO])) break; if (sp > XB_SPIN_CAP) { atomicAdd(&bar[XB_TMO], 1u); break; } }
  }
  nloc = mine > 0u ? mine : 1u; nx = cnt > 0u ? cnt : 1u;
}
DI void xcd_barrier(const XcdBarrier& b) {
  asm volatile("s_waitcnt vmcnt(0)" ::: "memory");
  __syncthreads();
  if (threadIdx.x == 0) {
    unsigned* bar = b.bar;
    __builtin_amdgcn_s_waitcnt(0);
    unsigned nloc = b.st[0], nx = b.st[1];
    if (nloc == 0u) { xcd_barrier_complete(bar, b.x, nloc, nx); b.st[0] = nloc; b.st[1] = nx; }
    const unsigned old = xb_add(&bar[XB_XSUB(b.x)], 1u);
    const unsigned gen = old / nloc;
    if (old + 1u == (gen + 1u) * nloc) {
      __builtin_amdgcn_fence(__ATOMIC_RELEASE, "agent");
      asm volatile("s_waitcnt vmcnt(0)" ::: "memory");
      const unsigned og = xb_add(&bar[XB_TOP], 1u);
      const unsigned tg = og / nx;
      if (og + 1u == (tg + 1u) * nx) xb_add(&bar[XB_TOPGEN], 1u);
      else XB_SPIN(xb_ld(&bar[XB_TOPGEN]) == tg, bar);
      __builtin_amdgcn_fence(__ATOMIC_ACQUIRE, "agent");
      xb_add(&bar[XB_XGEN(b.x)], 1u);
      asm volatile("s_waitcnt vmcnt(0)" ::: "memory");
    } else {
      XB_SPIN(xb_ld(&bar[XB_XGEN(b.x)]) == gen, bar);
      __builtin_amdgcn_fence(__ATOMIC_ACQUIRE, "agent");
      asm volatile("s_waitcnt vmcnt(0)" ::: "memory");
    }
  }
  __syncthreads();
}
DI void lds_barrier() { asm volatile("s_waitcnt lgkmcnt(0)\n\ts_barrier" ::: "memory"); }

DI void phase0a(const Params& p) {
  float* CST = (float*)(p.ws + WS_CST);
  for (int idx = blockIdx.x * 256 + otid(); idx < 1024 * 160; idx += gridDim.x * 256) {
    const int k = idx / 160, r = idx - k * 160;
    float v = 0.f;
    if (r < 8) v = silu(p.c_p[r * 1024 + k]); else if (r < 136) v = silu(p.c_s[(r - 8) * 1024 + k]);
    CST[idx] = v;
  }
}
DI void phase0(const Params& p, char* smem) {
  float* MOD = (float*)(p.ws + WS_MOD);
  const float* CST = (const float*)(p.ws + WS_CST);
  const int nmod = gridDim.x >= 384 ? 192 : 0;
  const int tstep = gridDim.x - nmod;
  if (nmod == 0 || (int)blockIdx.x < nmod)
  for (int task = blockIdx.x; task < 192; task += gridDim.x) {
    int tid = threadIdx.x; asm volatile("" : "+v"(tid));
    {
      const int l = task / 96, cb = task % 96;
      const int lane = tid & 63, wave = tid >> 6;
      float* red = (float*)smem;
      __syncthreads();
      for (int i = tid; i < 160 * 32; i += 256) red[i] = 0.f;
      __syncthreads();
      f32x16 acc[5];
#pragma unroll
      for (int mt = 0; mt < 5; ++mt)
#pragma unroll
        for (int i = 0; i < 16; ++i) acc[mt][i] = 0.f;
      const float* wm = p.w_mod + (size_t)l * 1024 * 3072 + cb * 32 + (lane & 31) + (size_t)(wave * 256 + (lane >> 5)) * 3072;
      const float* ct = CST + (lane & 31) + (wave * 256 + (lane >> 5)) * 160;
      float bA[8], aA[8][5], bB[8], aB[8][5];
#define MOD_LOAD(bb, aa, g) { _Pragma("unroll") for (int u = 0; u < 8; ++u) { const int kk = 2 * ((g) * 8 + u); bb[u] = __builtin_nontemporal_load(wm + (size_t)kk * 3072); _Pragma("unroll") for (int mt = 0; mt < 5; ++mt) aa[u][mt] = ct[kk * 160 + mt * 32]; } }
#define MOD_COMP(bb, aa) { _Pragma("unroll") for (int u = 0; u < 8; ++u) { _Pragma("unroll") for (int mt = 0; mt < 5; ++mt) acc[mt] = __builtin_amdgcn_mfma_f32_32x32x2f32(aa[u][mt], bb[u], acc[mt], 0, 0, 0); } }
      MOD_LOAD(bA, aA, 0);
#pragma unroll 1
      for (int g = 0; g < 16; g += 2) {
        MOD_LOAD(bB, aB, g + 1);
        MOD_COMP(bA, aA);
        { const int g2 = g + 2 < 16 ? g + 2 : 15; MOD_LOAD(bA, aA, g2); }
        MOD_COMP(bB, aB);
      }
#pragma unroll
      for (int mt = 0; mt < 5; ++mt)
#pragma unroll
        for (int i = 0; i < 16; ++i) atomicAdd(&red[(mt * 32 + rowi(i, lane)) * 32 + (lane & 31)], acc[mt][i]);
      __syncthreads();
      {
        const int col = tid & 31;
        const float bm = p.b_mod[l * 3072 + cb * 32 + col];
        for (int r = tid >> 5; r < 136; r += 8) MOD[((size_t)l * 136 + r) * 3072 + cb * 32 + col] = red[r * 32 + col] + bm;
      }
    }
  }
  if ((int)blockIdx.x >= nmod) {
    {
      const int tid = threadIdx.x;
      const int TOT = (4096 + 1024 + 4224 + 1024) * 128;
      const int nthr = tstep * 256;
      for (int it0 = ((int)blockIdx.x - nmod) * 256 + tid; it0 < TOT; it0 += 2 * nthr) {
        float v[2][8]; bf16_t* dptr[2]; bool ok[2];
#pragma unroll
        for (int u = 0; u < 2; ++u) {
          int it = it0 + u * nthr; ok[u] = it < TOT; if (!ok[u]) it = it0;
          const float* src; int ldw, N, mode; bf16_t* dst;
          if (it < 4096 * 128) { src = p.wa_in; ldw = 4096; N = 4096; mode = 1; dst = (bf16_t*)(p.ws + WS_WT1); }
          else if (it < 5120 * 128) { it -= 4096 * 128; src = p.wa_out; ldw = 1024; N = 1024; mode = 0; dst = (bf16_t*)(p.ws + WS_WT2); }
          else if (it < 9344 * 128) { it -= 5120 * 128; src = p.wb_in; ldw = 4112; N = 4224; mode = 2; dst = (bf16_t*)(p.ws + WS_WT3); }
          else { it -= 9344 * 128; src = p.wb_out; ldw = 1024; N = 1024; mode = 0; dst = (bf16_t*)(p.ws + WS_WT4); }
          const int k8 = it / N, np = it - k8 * N;
          int sc = np;
          if (mode == 1) { const int nt128 = np >> 7, seg = (np >> 5) & 3, j = np & 31; sc = (seg == 0 ? 1024 : seg == 1 ? 2048 : seg == 2 ? 0 : 3072) + nt128 * 32 + j; }
          const bool valid = !(mode == 2 && np >= 4112);
          const float* sp = src + (size_t)(k8 * 8) * ldw + (valid ? sc : 0);
#pragma unroll
          for (int j = 0; j < 8; ++j) { const float x = __builtin_nontemporal_load(sp + (size_t)j * ldw); v[u][j] = valid ? x : 0.f; }
          dptr[u] = dst + ((size_t)((np >> 5) * 64 + (k8 >> 1)) * 64 + (np & 31) + 32 * (k8 & 1)) * 8;
        }
#pragma unroll
        for (int u = 0; u < 2; ++u) if (ok[u]) {
          u32x4 o; o[0] = pk2(v[u][0], v[u][1]); o[1] = pk2(v[u][2], v[u][3]); o[2] = pk2(v[u][4], v[u][5]); o[3] = pk2(v[u][6], v[u][7]);
          *(u32x4*)dptr[u] = o;
        }
      }
    }
  }
}

DI void phase1(const Params& p) {
  const float* MOD = (const float*)(p.ws + WS_MOD);
  bf16_t* AB = (bf16_t*)(p.ws + WS_ABUF);
  for (int i = blockIdx.x * 256 + otid(); i < MTOT * 128; i += gridDim.x * 256) {
    const int row = i >> 7, c8 = (i & 127) * 8;
    const float* xr = xrow(p, row) + c8;
    const float* md = MOD + (size_t)bidx(row) * 3072 + c8;
    const f32x4 x0 = __builtin_nontemporal_load((const f32x4*)xr), x1 = __builtin_nontemporal_load((const f32x4*)(xr + 4));
    const f32x4 sh0 = *(const f32x4*)md, sh1 = *(const f32x4*)(md + 4), sc0 = *(const f32x4*)(md + 1024), sc1 = *(const f32x4*)(md + 1028);
    u32x4 o;
    o[0] = pk2(x0[0] * (1.f + sc0[0]) + sh0[0], x0[1] * (1.f + sc0[1]) + sh0[1]);
    o[1] = pk2(x0[2] * (1.f + sc0[2]) + sh0[2], x0[3] * (1.f + sc0[3]) + sh0[3]);
    o[2] = pk2(x1[0] * (1.f + sc1[0]) + sh1[0], x1[1] * (1.f + sc1[1]) + sh1[1]);
    o[3] = pk2(x1[2] * (1.f + sc1[2]) + sh1[2], x1[3] * (1.f + sc1[3]) + sh1[3]);
    *(u32x4*)(AB + (size_t)row * 1024 + c8) = o;
  }
}

template <int MI, class Epi>
DI void gemm_phase(const bf16_t* __restrict__ A, const bf16_t* __restrict__ Bt, const int ntN, char* smem, const Epi& epi) {
  constexpr int BM = 64 * MI;
  bf16_t* sA = (bf16_t*)smem;
  const int ntiles = (MTOT / BM) * ntN;
  for (int t = blockIdx.x; t < ntiles; t += gridDim.x) {
    const int tid = otid(), lane = tid & 63, wave = tid >> 6, wr = wave >> 1, wc = wave & 1;
    const int lrow = tid >> 3, lkc = (tid & 7) * 8;
    const int mt = t / ntN, nt = t - mt * ntN;
    const bf16_t* Ag = A + ((size_t)mt * BM + lrow) * 1024 + lkc;
    const bf16_t* Bf = Bt + (size_t)(nt * 4 + wc * 2) * 64 * 512 + lane * 8;
    f32x16 acc[MI][2];
#pragma unroll
    for (int mi = 0; mi < MI; ++mi)
#pragma unroll
      for (int nj = 0; nj < 2; ++nj)
#pragma unroll
        for (int i = 0; i < 16; ++i) acc[mi][nj][i] = 0.f;
    typename Epi::Pre pre;
    epi.prefetch(mt * BM + wr * (32 * MI), nt, wc, lane, pre);
    u32x4 ra[2 * MI];
    bf16x8 bfr[2][4];
#pragma unroll
    for (int q = 0; q < 2 * MI; ++q) ra[q] = *(const u32x4*)(Ag + (size_t)q * 32 * 1024);
#pragma unroll
    for (int nj = 0; nj < 2; ++nj)
#pragma unroll
      for (int ks = 0; ks < 4; ++ks) bfr[nj][ks] = *(const bf16x8*)(Bf + (size_t)(nj * 64 + ks) * 512);
    for (int kt = 0; kt < 16; ++kt) {
      lds_barrier();
#pragma unroll
      for (int q = 0; q < 2 * MI; ++q) *(u32x4*)(sA + (lrow + 32 * q) * 72 + lkc) = ra[q];
      lds_barrier();
      const int kn = kt < 15 ? kt + 1 : 15;
#pragma unroll
      for (int q = 0; q < 2 * MI; ++q) ra[q] = *(const u32x4*)(Ag + (size_t)q * 32 * 1024 + kn * 64);
      __builtin_amdgcn_sched_barrier(0);
      __builtin_amdgcn_s_setprio(2);
#pragma unroll
      for (int ks = 0; ks < 4; ++ks) {
        bf16x8 a[MI];
#pragma unroll
        for (int mi = 0; mi < MI; ++mi) a[mi] = *(const bf16x8*)(sA + (wr * (32 * MI) + mi * 32 + (lane & 31)) * 72 + ks * 16 + (lane >> 5) * 8);
#pragma unroll
        for (int mi = 0; mi < MI; ++mi)
#pragma unroll
          for (int nj = 0; nj < 2; ++nj) acc[mi][nj] = MFMA32(a[mi], bfr[nj][ks], acc[mi][nj]);
#pragma unroll
        for (int nj = 0; nj < 2; ++nj) bfr[nj][ks] = *(const bf16x8*)(Bf + (size_t)(nj * 64 + kn * 4 + ks) * 512);
      }
      __builtin_amdgcn_s_setprio(0);
    }
    epi(mt * BM + wr * (32 * MI), nt, wc, lane, acc, pre);
  }
}

DI unsigned pair_pk(float v0, float v1, int lane) {
  const bool odd = lane & 1;
  const float send = odd ? v0 : v1;
  const float recv = __builtin_bit_cast(float, __builtin_amdgcn_update_dpp(0, __builtin_bit_cast(int, send), 0xB1, 0xF, 0xF, true));
  return odd ? pk2(recv, v1) : pk2(v0, recv);
}
template <int MI> struct Epi1 {
  struct Pre {};
  DI void prefetch(int, int, int, int, Pre&) const {}
  bf16_t* CH; bf16_t* G1; float* out;
  template <bool TAIL> DI void body(int row0, int nt, int wc, int lane, const f32x16 (&acc)[MI][2]) const {
    const int ch = nt * 32 + (lane & 31);
    bf16_t* dst = (wc == 0 ? CH : G1) + (ch & ~1);
#pragma unroll
    for (int mi = 0; mi < MI; ++mi)
#pragma unroll
      for (int ip = 0; ip < 8; ++ip) {
        float v[2];
#pragma unroll
        for (int u = 0; u < 2; ++u) {
          const int i = 2 * ip + u;
          v[u] = wc == 0 ? acc[mi][0][i] * acc[mi][1][i] : acc[mi][0][i] * silu(acc[mi][1][i]);
          if (TAIL && wc == 0) {
            const int row = row0 + mi * 32 + rowi(i, lane);
            if (row < MP) { const int t = row & 2047; if (t >= 2046) out[OUT_CAP + (size_t)((row >> 11) * 2 + (t - 2046)) * 1024 + ch] = v[u]; }
            else { const int t = row & 7; if (t >= 6) out[OUT_CAS + (size_t)(((row - MP) >> 3) * 2 + (t - 6)) * 1024 + ch] = v[u]; }
          }
        }
        const int row = row0 + mi * 32 + rowi(2 * ip + (lane & 1), lane);
        *(unsigned*)(dst + (size_t)row * 1024) = pair_pk(v[0], v[1], lane);
      }
  }
  DI void operator()(int row0, int nt, int wc, int lane, const f32x16 (&acc)[MI][2], const Pre& pre) const {
    const bool tail = row0 >= MP || ((row0 + 32 * MI - 1) & 2047) >= 2046;
    if (tail) body<true>(row0, nt, wc, lane, acc); else body<false>(row0, nt, wc, lane, acc);
  }
};
template <int MI> struct Epi2 {
  Params p;
  struct Pre { float v[MI][2][16]; };
  DI void prefetch(int row0, int nt, int wc, int lane, Pre& pre) const {
    const float* base = xrow(p, row0 + 4 * (lane >> 5)) + nt * 128 + wc * 64 + (lane & 31);
#pragma unroll
    for (int mi = 0; mi < MI; ++mi)
#pragma unroll
      for (int i = 0; i < 16; ++i)
#pragma unroll
        for (int nj = 0; nj < 2; ++nj) pre.v[mi][nj][i] = __builtin_nontemporal_load(base + (mi * 32 + (i & 3) + 8 * (i >> 2)) * 1024 + nj * 32);
  }
  template <bool PROMPT> DI void body(int row0, int nt, int wc, int lane, const f32x16 (&acc)[MI][2], const Pre& pre) const {
    const float* MOD = (const float*)(p.ws + WS_MOD);
    const int c0 = nt * 128 + wc * 64 + (lane & 31);
    float g0 = 0.f, g1 = 0.f;
    if (PROMPT) { const float* gt = MOD + (size_t)(row0 >> 11) * 3072 + 2048 + c0; g0 = gt[0]; g1 = gt[32]; }
#pragma unroll
    for (int mi = 0; mi < MI; ++mi)
#pragma unroll
      for (int i = 0; i < 16; ++i) {
        const int row = row0 + mi * 32 + rowi(i, lane);
        if (!PROMPT) { const float* gt = MOD + (size_t)bidx(row) * 3072 + 2048 + c0; g0 = gt[0]; g1 = gt[32]; }
        float* yp = p.out + OUT_Y + (size_t)row * 1024 + c0;
        yp[0] = ALPHA_F * pre.v[mi][0][i] + g0 * acc[mi][0][i];
        yp[32] = ALPHA_F * pre.v[mi][1][i] + g1 * acc[mi][1][i];
      }
  }
  DI void operator()(int row0, int nt, int wc, int lane, const f32x16 (&acc)[MI][2], const Pre& pre) const {
    if (row0 < MP) body<true>(row0, nt, wc, lane, acc, pre); else body<false>(row0, nt, wc, lane, acc, pre);
  }
};
template <int MI> struct Epi3 {
  Params p;
  struct Pre {};
  DI void prefetch(int, int, int, int, Pre&) const {}
  template <bool TAIL> DI void body(int row0, int nt, int wc, int lane, const f32x16 (&acc)[MI][2]) const {
    bf16_t* QKV = (bf16_t*)(p.ws + WS_QKV); bf16_t* Z = (bf16_t*)(p.ws + WS_Z); float* BA = (float*)(p.ws + WS_BA);
    if (nt < 32) {
#pragma unroll
      for (int nj = 0; nj < 2; ++nj) {
        const int col = nt * 128 + wc * 64 + nj * 32 + (lane & 31);
        bf16_t* dst = nt < 24 ? QKV + (col & ~1) : Z + ((col - 3072) & ~1);
        const int ld = nt < 24 ? 3072 : 1024;
#pragma unroll
        for (int mi = 0; mi < MI; ++mi)
#pragma unroll
          for (int ip = 0; ip < 8; ++ip) {
            if (TAIL && nt < 24) {
#pragma unroll
              for (int u = 0; u < 2; ++u) {
                const int row = row0 + mi * 32 + rowi(2 * ip + u, lane);
                const float v = acc[mi][nj][2 * ip + u];
                if (row < MP) { const int t = row & 2047; if (t >= 2045) p.out[OUT_CBP + (size_t)((row >> 11) * 3 + (t - 2045)) * 3072 + col] = v; }
                else { const int t = row & 7; if (t >= 5) p.out[OUT_CBS + (size_t)(((row - MP) >> 3) * 3 + (t - 5)) * 3072 + col] = v; }
              }
            }
            const int row = row0 + mi * 32 + rowi(2 * ip + (lane & 1), lane);
            *(unsigned*)(dst + (size_t)row * ld) = pair_pk(acc[mi][nj][2 * ip], acc[mi][nj][2 * ip + 1], lane);
          }
      }
    } else if (wc == 0 && (lane & 31) < 16) {
#pragma unroll
      for (int mi = 0; mi < MI; ++mi)
#pragma unroll
        for (int i = 0; i < 16; ++i) BA[(size_t)(row0 + mi * 32 + rowi(i, lane)) * 16 + (lane & 31)] = acc[mi][0][i];
    }
  }
  DI void operator()(int row0, int nt, int wc, int lane, const f32x16 (&acc)[MI][2], const Pre& pre) const {
    const bool tail = row0 >= MP || ((row0 + 32 * MI - 1) & 2047) >= 2045;
    if (tail) body<true>(row0, nt, wc, lane, acc); else body<false>(row0, nt, wc, lane, acc);
  }
};
template <int MI> struct Epi4 {
  Params p;
  struct Pre { float v[MI][2][16]; };
  DI void prefetch(int row0, int nt, int wc, int lane, Pre& pre) const {
    const float* base = p.out + OUT_Y + (size_t)(row0 + 4 * (lane >> 5)) * 1024 + nt * 128 + wc * 64 + (lane & 31);
#pragma unroll
    for (int mi = 0; mi < MI; ++mi)
#pragma unroll
      for (int i = 0; i < 16; ++i)
#pragma unroll
        for (int nj = 0; nj < 2; ++nj) pre.v[mi][nj][i] = __builtin_nontemporal_load(base + (mi * 32 + (i & 3) + 8 * (i >> 2)) * 1024 + nj * 32);
  }
  template <bool PROMPT> DI void body(int row0, int nt, int wc, int lane, const f32x16 (&acc)[MI][2], const Pre& pre) const {
    const float* MOD = (const float*)(p.ws + WS_MOD) + (size_t)136 * 3072;
    const float* ST = (const float*)(p.ws + WS_STATS);
    const int c0 = nt * 128 + wc * 64 + (lane & 31);
    const float lg0 = p.ln_g[c0], lg1 = p.ln_g[c0 + 32], lb0 = p.ln_b[c0], lb1 = p.ln_b[c0 + 32];
    float g0 = 0.f, g1 = 0.f;
    if (PROMPT) { const float* gt = MOD + (size_t)(row0 >> 11) * 3072 + 2048 + c0; g0 = gt[0]; g1 = gt[32]; }
#pragma unroll
    for (int mi = 0; mi < MI; ++mi)
#pragma unroll
      for (int i = 0; i < 16; ++i) {
        const int row = row0 + mi * 32 + rowi(i, lane);
        const float mu = ST[row * 2], rstd = ST[row * 2 + 1];
        if (!PROMPT) { const float* gt = MOD + (size_t)bidx(row) * 3072 + 2048 + c0; g0 = gt[0]; g1 = gt[32]; }
        float* yp = p.out + OUT_Y + (size_t)row * 1024 + c0;
        yp[0] = ALPHA_F * ((pre.v[mi][0][i] - mu) * rstd * lg0 + lb0) + g0 * acc[mi][0][i];
        yp[32] = ALPHA_F * ((pre.v[mi][1][i] - mu) * rstd * lg1 + lb1) + g1 * acc[mi][1][i];
      }
  }
  DI void operator()(int row0, int nt, int wc, int lane, const f32x16 (&acc)[MI][2], const Pre& pre) const {
    if (row0 < MP) body<true>(row0, nt, wc, lane, acc, pre); else body<false>(row0, nt, wc, lane, acc, pre);
  }
};

DI void phase3(const Params& p) {
  const bf16_t* CH = (const bf16_t*)(p.ws + WS_CH); const bf16_t* G1 = (const bf16_t*)(p.ws + WS_G1);
  bf16_t* AB = (bf16_t*)(p.ws + WS_ABUF);
  for (int i = blockIdx.x * 256 + otid(); i < MTOT * 128; i += gridDim.x * 256) {
    const int row = i >> 7, c8 = (i & 127) * 8;
    const bool smp = row >= MP;
    const int t = smp ? (row & 7) : (row & 2047);
    float cur[8], p1[8], p2[8], g[8];
    { const u32x4 r = *(const u32x4*)(CH + (size_t)row * 1024 + c8);
#pragma unroll
      for (int e = 0; e < 4; ++e) { cur[2 * e] = bflo(r[e]); cur[2 * e + 1] = bfhi(r[e]); } }
    { const u32x4 r = __builtin_nontemporal_load((const u32x4*)(G1 + (size_t)row * 1024 + c8));
#pragma unroll
      for (int e = 0; e < 4; ++e) { g[2 * e] = bflo(r[e]); g[2 * e + 1] = bfhi(r[e]); } }
    if (t >= 1) { const u32x4 r = *(const u32x4*)(CH + (size_t)(row - 1) * 1024 + c8);
#pragma unroll
      for (int e = 0; e < 4; ++e) { p1[2 * e] = bflo(r[e]); p1[2 * e + 1] = bfhi(r[e]); } }
    else if (smp) { const float* b = p.st_conv_a + ((size_t)((row - MP) >> 3) * 2 + 1) * 1024 + c8;
#pragma unroll
      for (int e = 0; e < 8; ++e) p1[e] = b[e]; }
    else {
#pragma unroll
      for (int e = 0; e < 8; ++e) p1[e] = 0.f; }
    if (t >= 2) { const u32x4 r = *(const u32x4*)(CH + (size_t)(row - 2) * 1024 + c8);
#pragma unroll
      for (int e = 0; e < 4; ++e) { p2[2 * e] = bflo(r[e]); p2[2 * e + 1] = bfhi(r[e]); } }
    else if (smp) { const float* b = p.st_conv_a + ((size_t)((row - MP) >> 3) * 2 + t) * 1024 + c8;
#pragma unroll
      for (int e = 0; e < 8; ++e) p2[e] = b[e]; }
    else {
#pragma unroll
      for (int e = 0; e < 8; ++e) p2[e] = 0.f; }
    float o[8];
#pragma unroll
    for (int e = 0; e < 8; ++e) o[e] = g[e] * (p.wa_conv[c8 + e] * p2[e] + p.wa_conv[1024 + c8 + e] * p1[e] + p.wa_conv[2048 + c8 + e] * cur[e]);
    u32x4 ov; ov[0] = pk2(o[0], o[1]); ov[1] = pk2(o[2], o[3]); ov[2] = pk2(o[4], o[5]); ov[3] = pk2(o[6], o[7]);
    *(u32x4*)(AB + (size_t)row * 1024 + c8) = ov;
  }
}

template <int FINAL>
DI void ln_phase(const Params& p) {
  const int tid0 = otid();
  const int lane = tid0 & 63;
  const int gw = blockIdx.x * 4 + (tid0 >> 6), nw = gridDim.x * 4;
  const float* MOD1 = (const float*)(p.ws + WS_MOD) + (size_t)136 * 3072;
  float* ST = (float*)(p.ws + WS_STATS);
  bf16_t* AB = (bf16_t*)(p.ws + WS_ABUF);
  const float* lg = p.ln_g + (FINAL ? 1024 : 0); const float* lb = p.ln_b + (FINAL ? 1024 : 0);
  for (int row = gw; row < MTOT; row += nw) {
    float* yr = p.out + OUT_Y + (size_t)row * 1024;
    f32x4 v[4];
    float s = 0.f;
#pragma unroll
    for (int j = 0; j < 4; ++j) { v[j] = __builtin_nontemporal_load((const f32x4*)(yr + j * 256 + lane * 4)); s += v[j][0] + v[j][1] + v[j][2] + v[j][3]; }
#pragma unroll
    for (int o = 32; o >= 1; o >>= 1) s += __shfl_xor(s, o);
    const float mu = s * (1.f / 1024.f);
    float q = 0.f;
#pragma unroll
    for (int j = 0; j < 4; ++j)
#pragma unroll
      for (int e = 0; e < 4; ++e) { const float d = v[j][e] - mu; q += d * d; }
#pragma unroll
    for (int o = 32; o >= 1; o >>= 1) q += __shfl_xor(q, o);
    const float rstd = rsqrtf(q * (1.f / 1024.f) + 1e-5f);
    if (!FINAL && lane == 0) { ST[row * 2] = mu; ST[row * 2 + 1] = rstd; }
    const float* md = MOD1 + (size_t)bidx(row) * 3072;
#pragma unroll
    for (int j = 0; j < 4; ++j) {
      const int col = j * 256 + lane * 4;
      const f32x4 g4 = *(const f32x4*)(lg + col), b4 = *(const f32x4*)(lb + col);
      f32x4 x1;
#pragma unroll
      for (int e = 0; e < 4; ++e) x1[e] = (v[j][e] - mu) * rstd * g4[e] + b4[e];
      if (FINAL) { __builtin_nontemporal_store(x1, (f32x4*)(yr + col)); }
      else {
        const f32x4 sh = *(const f32x4*)(md + col), sc = *(const f32x4*)(md + 1024 + col);
        u32x2 o; o[0] = pk2(x1[0] * (1.f + sc[0]) + sh[0], x1[1] * (1.f + sc[1]) + sh[1]); o[1] = pk2(x1[2] * (1.f + sc[2]) + sh[2], x1[3] * (1.f + sc[3]) + sh[3]);
        *(u32x2*)(AB + (size_t)row * 1024 + col) = o;
      }
    }
  }
}

DI void gdn_chunk_local(const Params& p, char* smem0) {
  for (int task = blockIdx.x; task < 2048; task += gridDim.x) {
  int tid = threadIdx.x; asm volatile("" : "+v"(tid));
  int off0 = 0; asm volatile("" : "+v"(off0));
  char* smem = (char*)__builtin_assume_aligned(smem0 + (off0 & ~15), 16);
  const int lane = tid & 63, wave = __builtin_amdgcn_readfirstlane(tid >> 6);
  bf16_t* sq = (bf16_t*)smem;
  bf16_t* sk = sq + 64 * 136;
  bf16_t* sv = sk + 64 * 136;
  float* sAm = (float*)(smem + 3 * 17408);
  float* sc = (float*)(smem + 4 * 17408);
  float *sG = sc, *sBeta = sc + 64, *sRq = sc + 128, *sRk = sc + 192, *sSsq = sc + 256, *sSsk = sc + 320, *sBk = sc + 384, *sEg = sc + 448, *sKt = sc + 512;
  const bf16_t* QKV = (const bf16_t*)(p.ws + WS_QKV);
  const float* BA = (const float*)(p.ws + WS_BA);
  float* GL = (float*)(p.ws + WS_GL);
  bf16_t* Ug = (bf16_t*)(p.ws + WS_U); bf16_t* Wg = (bf16_t*)(p.ws + WS_W); bf16_t* ATT = (bf16_t*)(p.ws + WS_ATTN);
  bf16_t* QG = (bf16_t*)(p.out + OUT_SSS); bf16_t* KT = QG + (size_t)2048 * 8192;
  {
    const int n = task & 31, h = (task >> 5) & 7, b = task >> 8;
    const int row0 = b * 2048 + n * 64;
    {
      const int cg16 = tid & 15, rsub = tid >> 4;
      u32x4 raw[3][7];
#pragma unroll
      for (int seg = 0; seg < 3; ++seg)
#pragma unroll
        for (int r7 = 0; r7 < 7; ++r7) {
          const int ii = rsub * 4 - 3 + r7;
          if (n * 64 + ii >= 0) raw[seg][r7] = __builtin_nontemporal_load((const u32x4*)(QKV + (size_t)(row0 + ii) * 3072 + seg * 1024 + h * 128 + cg16 * 8));
          else { raw[seg][r7][0] = 0u; raw[seg][r7][1] = 0u; raw[seg][r7][2] = 0u; raw[seg][r7][3] = 0u; }
        }
#pragma unroll
      for (int seg = 0; seg < 3; ++seg) {
        const int colbase = seg * 1024 + h * 128 + cg16 * 8;
        float wt[4][8];
#pragma unroll
        for (int j = 0; j < 4; ++j) {
          const f32x4 w0 = *(const f32x4*)(p.wb_conv + j * 3072 + colbase), w1 = *(const f32x4*)(p.wb_conv + j * 3072 + colbase + 4);
#pragma unroll
          for (int e = 0; e < 4; ++e) { wt[j][e] = w0[e]; wt[j][4 + e] = w1[e]; }
        }
        bf16_t* dst = sq + seg * (64 * 136);
#pragma unroll
        for (int o4 = 0; o4 < 4; ++o4) {
          const int i = rsub * 4 + o4;
          float a8[8];
#pragma unroll
          for (int e = 0; e < 8; ++e) a8[e] = 0.f;
#pragma unroll
          for (int j = 0; j < 4; ++j) {
#pragma unroll
            for (int e = 0; e < 4; ++e) { a8[2 * e] += wt[j][2 * e] * bflo(raw[seg][o4 + j][e]); a8[2 * e + 1] += wt[j][2 * e + 1] * bfhi(raw[seg][o4 + j][e]); }
          }
          float ss = 0.f;
#pragma unroll
          for (int e = 0; e < 8; ++e) { a8[e] = silu(a8[e]); ss += a8[e] * a8[e]; }
          u32x4 o; o[0] = pk2(a8[0], a8[1]); o[1] = pk2(a8[2], a8[3]); o[2] = pk2(a8[4], a8[5]); o[3] = pk2(a8[6], a8[7]);
          *(u32x4*)(dst + i * 136 + cg16 * 8) = o;
          if (seg < 2) {
#pragma unroll
            for (int o2 = 8; o2 >= 1; o2 >>= 1) ss += __shfl_xor(ss, o2);
            if (cg16 == 0) sSsq[seg * 64 + i] = ss;
          }
        }
      }
    }
    __syncthreads();
    if (tid < 64) {
      const int row = row0 + tid;
      const float bb = BA[(size_t)row * 16 + h], aa = BA[(size_t)row * 16 + 8 + h];
      const float beta = 1.f / (1.f + expf(-bb));
      const float xx = aa + p.wb_dt_bias[h];
      const float sp = xx > 20.f ? xx : log1pf(expf(xx));
      const float g = -expf(p.wb_a_log[h]) * sp;
      float G = g;
#pragma unroll
      for (int off = 1; off < 64; off <<= 1) { const float tv = __shfl_up(G, off); if (lane >= off) G += tv; }
      const float Gl = __shfl(G, 63);
      const float rk = rsqrtf(sSsk[tid] + 1e-6f), rq = rsqrtf(sSsq[tid] + 1e-6f) * 0.08838834764831845f;
      const float eg = expf(G);
      sG[tid] = G; sBeta[tid] = beta; sRq[tid] = rq * eg; sRk[tid] = rk; sBk[tid] = rk * beta * eg; sEg[tid] = rq; sKt[tid] = rk * expf(Gl - G);
      if (tid == 63) GL[task] = eg;
    }
    __syncthreads();
    {
      bf16_t* qgo = QG + (size_t)task * 8192; bf16_t* kto = KT + (size_t)task * 8192;
#pragma unroll
      for (int c4 = 0; c4 < 4; ++c4) {
        const int o = tid + 256 * c4;
        {
          const int mt = o >> 9, s = (o >> 6) & 7, ln = o & 63, i = mt * 32 + (ln & 31), hh = ln >> 5;
          const u32x2 lo = *(const u32x2*)(sq + i * 136 + s * 16 + hh * 4), hi = *(const u32x2*)(sq + i * 136 + s * 16 + 8 + hh * 4);
          const float f = sRq[i];
          u32x4 ov; ov[0] = pk2(bflo(lo[0]) * f, bfhi(lo[0]) * f); ov[1] = pk2(bflo(lo[1]) * f, bfhi(lo[1]) * f);
          ov[2] = pk2(bflo(hi[0]) * f, bfhi(hi[0]) * f); ov[3] = pk2(bflo(hi[1]) * f, bfhi(hi[1]) * f);
          *(u32x4*)(qgo + (size_t)o * 8) = ov;
        }
        {
          const int mt = o >> 8, s = (o >> 6) & 3, ln = o & 63, m = mt * 32 + (ln & 31), hh = ln >> 5;
          float vv[8];
#pragma unroll
          for (int e = 0; e < 8; ++e) { const int j = s * 16 + (e >> 2) * 8 + hh * 4 + (e & 3); vv[e] = bf2f(sk[j * 136 + m]) * sKt[j]; }
          u32x4 ov; ov[0] = pk2(vv[0], vv[1]); ov[1] = pk2(vv[2], vv[3]); ov[2] = pk2(vv[4], vv[5]); ov[3] = pk2(vv[6], vv[7]);
          *(u32x4*)(kto + (size_t)o * 8) = ov;
        }
      }
    }
    const int mat = wave >> 1, gmi = wave & 1;
    f32x16 g2[2];
#pragma unroll
    for (int nj = 0; nj < 2; ++nj)
#pragma unroll
      for (int i = 0; i < 16; ++i) g2[nj][i] = 0.f;
    {
      const bf16_t* srcA = mat ? sq : sk;
#pragma unroll
      for (int ks = 0; ks < 8; ++ks) {
        const bf16x8 a = *(const bf16x8*)(srcA + (gmi * 32 + (lane & 31)) * 136 + ks * 16 + (lane >> 5) * 8);
#pragma unroll
        for (int nj = 0; nj < 2; ++nj) {
          const bf16x8 bb = *(const bf16x8*)(sk + (nj * 32 + (lane & 31)) * 136 + ks * 16 + (lane >> 5) * 8);
          g2[nj] = MFMA32(a, bb, g2[nj]);
        }
      }
    }
    __syncthreads();
#pragma unroll
    for (int nj = 0; nj < 2; ++nj)
#pragma unroll
      for (int r = 0; r < 16; ++r) {
        const int i = gmi * 32 + rowi(r, lane), j = nj * 32 + (lane & 31);
        const float dec = __expf(fminf(sG[i] - sG[j], 0.f));
        if (mat == 0) {
          sAm[i * 68 + j] = (i > j) ? sBeta[i] * sRk[i] * sRk[j] * dec * g2[nj][r] : 0.f;
        } else {
          const float val = (i >= j) ? sEg[i] * sRk[j] * dec * g2[nj][r] : 0.f;
          const int s = j >> 4, q = j & 15, e = (q >> 3) * 4 + (q & 3), hh = (q >> 2) & 1, ln = (i & 31) + 32 * hh;
          sq[((gmi * 4 + s) * 64 + ln) * 8 + e] = (bf16_t)f2bf(val);
        }
      }
    __syncthreads();
#pragma unroll
    for (int c = 0; c < 2; ++c) { const int o = tid + 256 * c; *(u32x4*)(ATT + (size_t)task * 4096 + (size_t)o * 8) = *(const u32x4*)(sq + o * 8); }
    typedef float f32x2 __attribute__((ext_vector_type(2)));
    f32x2 xv[32];
    {
      const bool isV = tid < 128;
      const bf16_t* src = isV ? (sv + tid) : (sk + (tid - 128));
      const float* scl = isV ? sBeta : sBk;
#pragma unroll
      for (int i = 0; i < 64; ++i) {
        f32x2 r0 = {bf2f(src[i * 136]) * scl[i], 0.f}, r1 = {0.f, 0.f};
#pragma unroll
        for (int m = 0; m < i / 2; ++m) {
          const f32x2 a2 = *(const f32x2*)(sAm + i * 68 + 2 * m);
          if (m & 1) r1 -= a2 * xv[m]; else r0 -= a2 * xv[m];
        }
        r0 += r1;
        float r = r0[0] + r0[1];
        if (i & 1) r -= sAm[i * 68 + i - 1] * xv[i / 2][0];
        xv[i / 2][i & 1] = r;
      }
    }
#define XS(i) xv[(i) >> 1][(i) & 1]
    __syncthreads();
    if (tid < 128) {
      const int s = tid >> 5, nn = tid & 31;
#pragma unroll
      for (int i = 0; i < 64; ++i) {
        const int mt = i >> 5, ii = i & 31, hh = (ii >> 2) & 1, r = (ii >> 3) * 4 + (ii & 3);
        sv[((s * 2 + mt) * 64 + nn + 32 * hh) * 16 + r] = (bf16_t)f2bf(XS(i));
      }
    } else {
      const int c = tid - 128, s = c >> 4, q = c & 15, e = (q >> 3) * 4 + (q & 3), hh = (q >> 2) & 1;
#pragma unroll
      for (int i = 0; i < 64; ++i) {
        const int mt = i >> 5;
        sk[((mt * 8 + s) * 64 + (i & 31) + 32 * hh) * 8 + e] = (bf16_t)f2bf(XS(i));
      }
    }
    __syncthreads();
#pragma unroll
    for (int c = 0; c < 4; ++c) {
      const int o = tid + 256 * c;
      *(u32x4*)(Ug + (size_t)task * 8192 + (size_t)o * 8) = *(const u32x4*)(sv + o * 8);
      *(u32x4*)(Wg + (size_t)task * 8192 + (size_t)o * 8) = *(const u32x4*)(sk + o * 8);
    }
    __syncthreads();
  }
  }
}

DI void gdn_scan(const Params& p, char* smem) {
  if (blockIdx.x >= 256) return;
  const int tid = otid(), lane = tid & 63, wave = __builtin_amdgcn_readfirstlane(tid >> 6);
  const int xcd = blockIdx.x & 7, yy = blockIdx.x >> 3;
  const int bh = xcd * 8 + (yy >> 2), s = yy & 3, h = bh & 7, b = bh >> 3;
  bf16x8* Sfrag = (bf16x8*)smem;
  bf16x8* Vfrag = Sfrag + 512;
  const bf16_t* Ug = (const bf16_t*)(p.ws + WS_U); const bf16_t* Wg = (const bf16_t*)(p.ws + WS_W); const bf16_t* ATT = (const bf16_t*)(p.ws + WS_ATTN);
  const bf16_t* QG = (const bf16_t*)(p.out + OUT_SSS); const bf16_t* KT = QG + (size_t)2048 * 8192;
  const float* GL = (const float*)(p.ws + WS_GL);
  bf16_t* O = (bf16_t*)(p.ws + WS_O);
  const size_t cbase = (size_t)(b * 8 + h) * 32;
  const bool isW = wave < 2; const int mi = wave & 1;
  f32x16 S;
#pragma unroll
  for (int i = 0; i < 16; ++i) S[i] = 0.f;
  { bf16x8 z; for (int e = 0; e < 8; ++e) z[e] = 0; for (int o = tid; o < 512; o += 256) Sfrag[o] = z; }
  const bf16_t* aBase = (isW ? Wg : QG) + cbase * 8192 + (size_t)(mi * 8) * 512 + lane * 8;
  const bf16_t* kBase = KT + cbase * 8192 + (size_t)(wave * 4) * 512 + lane * 8;
  const bf16_t* tBase = ATT + cbase * 4096 + (size_t)(mi * 4) * 512 + lane * 8;
  const bf16_t* uBase = Ug + cbase * 8192 + (size_t)((s * 2 + mi) * 64 + lane) * 16;
  struct Regs { bf16x8 afr[8], kfr[4], tfr[4]; u32x4 ur[2]; };
  const float glv = GL[cbase + (lane & 31)];
  Regs R0, R1;
  auto load_all = [&](Regs& R, int n) {
#pragma unroll
    for (int ks = 0; ks < 8; ++ks) R.afr[ks] = *(const bf16x8*)(aBase + (size_t)n * 8192 + ks * 512);
#pragma unroll
    for (int k4 = 0; k4 < 4; ++k4) { R.kfr[k4] = *(const bf16x8*)(kBase + (size_t)n * 8192 + k4 * 512); R.tfr[k4] = *(const bf16x8*)(tBase + (size_t)n * 4096 + k4 * 512); }
    R.ur[0] = __builtin_nontemporal_load((const u32x4*)(uBase + (size_t)n * 8192)); R.ur[1] = __builtin_nontemporal_load((const u32x4*)(uBase + (size_t)n * 8192 + 8));
  };
  load_all(R0, 0);
  load_all(R1, 1);
  __syncthreads();
  auto step = [&](Regs& R, const int n) {
    const int nn = n + 2 < 32 ? n + 2 : 31;
    f32x16 acc0, acc1;
#pragma unroll
    for (int i = 0; i < 16; ++i) { acc0[i] = 0.f; acc1[i] = 0.f; }
#pragma unroll
    for (int ks = 0; ks < 8; ks += 2) {
      acc0 = MFMA32(R.afr[ks], Sfrag[ks * 64 + lane], acc0);
      acc1 = MFMA32(R.afr[ks + 1], Sfrag[(ks + 1) * 64 + lane], acc1);
    }
#pragma unroll
    for (int i = 0; i < 16; ++i) acc0[i] += acc1[i];
#pragma unroll
    for (int ks = 0; ks < 8; ++ks) R.afr[ks] = *(const bf16x8*)(aBase + (size_t)nn * 8192 + ks * 512);
    if (isW) {
      f32x16 vn;
#pragma unroll
      for (int e = 0; e < 4; ++e) {
        vn[2 * e] = bflo(R.ur[0][e]) - acc0[2 * e]; vn[2 * e + 1] = bfhi(R.ur[0][e]) - acc0[2 * e + 1];
        vn[8 + 2 * e] = bflo(R.ur[1][e]) - acc0[8 + 2 * e]; vn[8 + 2 * e + 1] = bfhi(R.ur[1][e]) - acc0[8 + 2 * e + 1];
      }
      Vfrag[(2 * mi) * 64 + lane] = pack8(vn, 0);
      Vfrag[(2 * mi + 1) * 64 + lane] = pack8(vn, 1);
      R.ur[0] = __builtin_nontemporal_load((const u32x4*)(uBase + (size_t)nn * 8192)); R.ur[1] = __builtin_nontemporal_load((const u32x4*)(uBase + (size_t)nn * 8192 + 8));
    }
    lds_barrier();
    if (!isW) {
#pragma unroll
      for (int k4 = 0; k4 < 4; ++k4) acc0 = MFMA32(R.tfr[k4], Vfrag[k4 * 64 + lane], acc0);
      bf16_t* op = O + (size_t)(b * 2048 + n * 64 + mi * 32) * 1024 + h * 128 + s * 32 + (lane & 30);
#pragma unroll
      for (int ip = 0; ip < 8; ++ip) *(unsigned*)(op + (size_t)rowi(2 * ip + (lane & 1), lane) * 1024) = pair_pk(acc0[2 * ip], acc0[2 * ip + 1], lane);
#pragma unroll
      for (int k4 = 0; k4 < 4; ++k4) R.tfr[k4] = *(const bf16x8*)(tBase + (size_t)nn * 4096 + k4 * 512);
    }
    const float gl = __builtin_bit_cast(float, __builtin_amdgcn_readlane(__builtin_bit_cast(int, glv), n));
#pragma unroll
    for (int i = 0; i < 16; ++i) S[i] *= gl;
#pragma unroll
    for (int k4 = 0; k4 < 4; ++k4) S = MFMA32(R.kfr[k4], Vfrag[k4 * 64 + lane], S);
#pragma unroll
    for (int k4 = 0; k4 < 4; ++k4) R.kfr[k4] = *(const bf16x8*)(kBase + (size_t)nn * 8192 + k4 * 512);
    Sfrag[(2 * wave) * 64 + lane] = pack8(S, 0);
    Sfrag[(2 * wave + 1) * 64 + lane] = pack8(S, 1);
    lds_barrier();
  };
#pragma unroll 1
  for (int n = 0; n < 32; n += 2) { step(R0, n); step(R1, n + 1); }
  float* so = p.out + OUT_SSP + ((size_t)(b * 8 + h) * 128 + wave * 32) * 128 + s * 32 + (lane & 31);
#pragma unroll
  for (int r = 0; r < 16; ++r) so[(size_t)rowi(r, lane) * 128] = S[r];
}

DI void sample_task(const Params& p, char* smem, int task) {
  const int tid = otid(), lane = tid & 63, wave = tid >> 6;
  const int bs = task >> 3, h = task & 7;
  float* fq = (float*)smem; float* fk = fq + 1024; float* fv = fk + 1024; float* red = fv + 1024; float* ored = red + 2048; float* scal = ored + 2048;
  const bf16_t* QKV = (const bf16_t*)(p.ws + WS_QKV); const float* BA = (const float*)(p.ws + WS_BA);
  const bf16_t* Z = (const bf16_t*)(p.ws + WS_Z); bf16_t* AB = (bf16_t*)(p.ws + WS_ABUF);
  const int rowb = MP + bs * 8;
#pragma unroll
  for (int it = 0; it < 12; ++it) {
    const int idx = tid + 256 * it;
    const int tok = idx / 384, cc = idx - tok * 384, seg = cc >> 7, c = cc & 127, col = seg * 1024 + h * 128 + c;
    float acc = 0.f;
#pragma unroll
    for (int j = 0; j < 4; ++j) {
      const int tt = tok + j;
      const float xs = __builtin_nontemporal_load(p.st_conv_b + ((size_t)bs * 3 + (tt < 3 ? tt : 2)) * 3072 + col);
      const float xq = bf2f(QKV[(size_t)(rowb + (tt >= 3 ? tt - 3 : 0)) * 3072 + col]);
      acc += p.wb_conv[j * 3072 + col] * (tt < 3 ? xs : xq);
    }
    (seg == 0 ? fq : (seg == 1 ? fk : fv))[tok * 128 + c] = silu(acc);
  }
  if (tid < 8) {
    const int row = rowb + tid;
    const float bb = BA[(size_t)row * 16 + h], aa = BA[(size_t)row * 16 + 8 + h];
    const float xx = aa + p.wb_dt_bias[h];
    const float sp = xx > 20.f ? xx : log1pf(expf(xx));
    scal[tid] = 1.f / (1.f + expf(-bb));
    scal[8 + tid] = expf(-expf(p.wb_a_log[h]) * sp);
  }
  __syncthreads();
#pragma unroll
  for (int rr = 0; rr < 4; ++rr) {
    const int r16 = wave * 4 + rr;
    float* ptr = r16 < 8 ? fq + r16 * 128 : fk + (r16 - 8) * 128;
    const float a0 = ptr[lane], a1 = ptr[lane + 64];
    float ss = a0 * a0 + a1 * a1;
#pragma unroll
    for (int o = 32; o >= 1; o >>= 1) ss += __shfl_xor(ss, o);
    const float f = rsqrtf(ss + 1e-6f) * (r16 < 8 ? 0.08838834764831845f : 1.f);
    ptr[lane] = a0 * f; ptr[lane + 64] = a1 * f;
  }
  __syncthreads();
  const int vcol = tid & 127, kh = tid >> 7;
  float S[64];
  {
    const float* sp = p.st_ssm + (((size_t)bs * 8 + h) * 128 + kh * 64) * 128 + vcol;
#pragma unroll
    for (int kk = 0; kk < 64; ++kk) S[kk] = __builtin_nontemporal_load(sp + (size_t)kk * 128);
  }
#pragma unroll 1
  for (int t = 0; t < 8; ++t) {
    const float* kt = fk + t * 128 + kh * 64;
    const float* qt = fq + t * 128 + kh * 64;
    float part = 0.f;
#pragma unroll
    for (int kk = 0; kk < 64; ++kk) part += kt[kk] * S[kk];
    red[(t * 2 + kh) * 128 + vcol] = part;
    __syncthreads();
    const float kS = red[(t * 2) * 128 + vcol] + red[(t * 2 + 1) * 128 + vcol];
    const float a = scal[8 + t], be = scal[t];
    const float d = be * (fv[t * 128 + vcol] - a * kS);
    float op = 0.f;
#pragma unroll
    for (int kk = 0; kk < 64; ++kk) { S[kk] = a * S[kk] + kt[kk] * d; op += qt[kk] * S[kk]; }
    ored[(t * 2 + kh) * 128 + vcol] = op;
  }
  {
    float* so = p.out + OUT_SSS + (((size_t)bs * 8 + h) * 128 + kh * 64) * 128 + vcol;
#pragma unroll
    for (int kk = 0; kk < 64; ++kk) __builtin_nontemporal_store(S[kk], so + (size_t)kk * 128);
  }
  __syncthreads();
  {
    const int tok = tid >> 5, c4 = (tid & 31) * 4;
    float o[4]; float ss = 0.f;
#pragma unroll
    for (int e = 0; e < 4; ++e) { o[e] = ored[(tok * 2) * 128 + c4 + e] + ored[(tok * 2 + 1) * 128 + c4 + e]; ss += o[e] * o[e]; }
#pragma unroll
    for (int o2 = 16; o2 >= 1; o2 >>= 1) ss += __shfl_xor(ss, o2);
    const float rstd = rsqrtf(ss * (1.f / 128.f) + 1e-6f);
    const u32x2 zr = *(const u32x2*)(Z + (size_t)(rowb + tok) * 1024 + h * 128 + c4);
    const float z0 = bflo(zr[0]), z1 = bfhi(zr[0]), z2 = bflo(zr[1]), z3 = bfhi(zr[1]);
    u32x2 ov;
    ov[0] = pk2(o[0] * rstd * p.wb_norm[c4] * silu(z0), o[1] * rstd * p.wb_norm[c4 + 1] * silu(z1));
    ov[1] = pk2(o[2] * rstd * p.wb_norm[c4 + 2] * silu(z2), o[3] * rstd * p.wb_norm[c4 + 3] * silu(z3));
    *(u32x2*)(AB + (size_t)(rowb + tok) * 1024 + h * 128 + c4) = ov;
  }
  __syncthreads();
}

DI void phase9(const Params& p, char* smem) {
  const int tid9 = otid();
  const int lane = tid9 & 63, wave = tid9 >> 6;
  const bf16_t* O = (const bf16_t*)(p.ws + WS_O); const bf16_t* Z = (const bf16_t*)(p.ws + WS_Z); bf16_t* AB = (bf16_t*)(p.ws + WS_ABUF);
  for (int task = blockIdx.x; task < 2048; task += gridDim.x) {
    if (task < 1024) { sample_task(p, smem, task); continue; }
    const int r0 = (task - 1024) * 16 + wave * 4;
#pragma unroll
    for (int rr = 0; rr < 4; ++rr) {
      const int row = r0 + rr;
#pragma unroll
      for (int j = 0; j < 4; ++j) {
        const int col = j * 256 + lane * 4;
        const u32x2 orw = __builtin_nontemporal_load((const u32x2*)(O + (size_t)row * 1024 + col));
        f32x4 o4; o4[0] = bflo(orw[0]); o4[1] = bfhi(orw[0]); o4[2] = bflo(orw[1]); o4[3] = bfhi(orw[1]);
        float ss = o4[0] * o4[0] + o4[1] * o4[1] + o4[2] * o4[2] + o4[3] * o4[3];
#pragma unroll
        for (int o2 = 16; o2 >= 1; o2 >>= 1) ss += __shfl_xor(ss, o2);
        const float rstd = rsqrtf(ss * (1.f / 128.f) + 1e-6f);
        const u32x2 zr = __builtin_nontemporal_load((const u32x2*)(Z + (size_t)row * 1024 + col));
        const f32x4 nw = *(const f32x4*)(p.wb_norm + (col & 127));
        u32x2 ov;
        ov[0] = pk2(o4[0] * rstd * nw[0] * silu(bflo(zr[0])), o4[1] * rstd * nw[1] * silu(bfhi(zr[0])));
        ov[1] = pk2(o4[2] * rstd * nw[2] * silu(bflo(zr[1])), o4[3] * rstd * nw[3] * silu(bfhi(zr[1])));
        *(u32x2*)(AB + (size_t)row * 1024 + col) = ov;
      }
    }
  }
}

__global__ void __launch_bounds__(256, 2) fwd_megakernel(Params p) {
  extern __shared__ __attribute__((aligned(16))) char smem[];
  cg::grid_group grid = cg::this_grid();
  if (p.out == nullptr) grid.sync();
  __shared__ uint4 xb_words;
  if (threadIdx.x == 0) xb_words = make_uint4(0u, 0u, 0u, 0u);
  __syncthreads();
  XcdBarrier xb = xcd_barrier_post((unsigned*)(p.ws + WS_BAR), (volatile LAS unsigned*)&xb_words);
#define GSYNC() xcd_barrier(xb)
  phase0a(p);
  GSYNC();
  phase0(p, smem);
  GSYNC();
  phase1(p);
  GSYNC();
  { Epi1<4> e{(bf16_t*)(p.ws + WS_CH), (bf16_t*)(p.ws + WS_G1), p.out}; gemm_phase<4>((const bf16_t*)(p.ws + WS_ABUF), (const bf16_t*)(p.ws + WS_WT1), 32, smem, e); }
  GSYNC();
  phase3(p);
  GSYNC();
  { Epi2<2> e{p}; gemm_phase<2>((const bf16_t*)(p.ws + WS_ABUF), (const bf16_t*)(p.ws + WS_WT2), 8, smem, e); }
  GSYNC();
  ln_phase<0>(p);
  GSYNC();
  { Epi3<4> e{p}; gemm_phase<4>((const bf16_t*)(p.ws + WS_ABUF), (const bf16_t*)(p.ws + WS_WT3), 33, smem, e); }
  GSYNC();
  gdn_chunk_local(p, smem);
  GSYNC();
  gdn_scan(p, smem);
  GSYNC();
  phase9(p, smem);
  GSYNC();
  { Epi4<2> e{p}; gemm_phase<2>((const bf16_t*)(p.ws + WS_ABUF), (const bf16_t*)(p.ws + WS_WT4), 8, smem, e); }
  GSYNC();
  ln_phase<1>(p);
}

extern "C" void kernel_launch(void* const* d_in, const int* in_sizes, int n_in, void* d_out, int out_size, void* d_ws, size_t ws_size, hipStream_t stream) {
  static int grid_blocks = 0;
  if (!grid_blocks) {
    int dev = 0, cus = 0, per_cu = 0;
    hipGetDevice(&dev);
    hipDeviceGetAttribute(&cus, hipDeviceAttributeMultiprocessorCount, dev);
    hipFuncSetAttribute((const void*)fwd_megakernel, hipFuncAttributeMaxDynamicSharedMemorySize, LDS_BYTES);
    hipOccupancyMaxActiveBlocksPerMultiprocessor(&per_cu, (const void*)fwd_megakernel, 256, LDS_BYTES);
    if (per_cu < 1) per_cu = 1;
    if (per_cu > 2) per_cu = 2;
    grid_blocks = cus * per_cu;
    if (ws_size < 247 * MiB) fprintf(stderr, "kernel_launch: workspace too small: %zu\n", ws_size);
  }
  Params p{};
  const float** pp = (const float**)&p;
  for (int i = 0; i < 20; ++i) pp[i] = (const float*)d_in[i];
  p.out = (float*)d_out; p.ws = (char*)d_ws;
  hipMemsetAsync((char*)d_ws + WS_BAR, 0, XCD_BAR_WORDS * 4, stream);
  void* args[] = {&p};
  hipError_t e = hipLaunchCooperativeKernel((const void*)fwd_megakernel, dim3(grid_blocks), dim3(256), args, LDS_BYTES, stream);
  if (e != hipSuccess) fprintf(stderr, "cooperative launch failed: %s (grid %d)\n", hipGetErrorString(e), grid_blocks);
}
```

```cpp
#include <hip/hip_runtime.h>
#include <hip/hip_cooperative_groups.h>
#include <cstdio>
namespace cg = cooperative_groups;

typedef unsigned short bf16_t;
typedef short bf16x8 __attribute__((ext_vector_type(8)));
typedef float f32x16 __attribute__((ext_vector_type(16)));
typedef float f32x4 __attribute__((ext_vector_type(4)));
typedef unsigned u32x4 __attribute__((ext_vector_type(4)));
typedef unsigned u32x2 __attribute__((ext_vector_type(2)));

#define DI __device__ __forceinline__
#define MFMA32(a, b, c) __builtin_amdgcn_mfma_f32_32x32x16_bf16((a), (b), (c), 0, 0, 0)

constexpr int MTOT = 17408, MP = 16384;
constexpr size_t MiB = 1ull << 20;
constexpr size_t WS_WT1 = 0, WS_WT2 = 8 * MiB, WS_WT3 = 10 * MiB, WS_WT4 = 19 * MiB, WS_MOD = 21 * MiB, WS_STATS = 25 * MiB,
                 WS_BA = 25 * MiB + 512 * 1024, WS_GL = 26 * MiB + 768 * 1024, WS_BAR = 26 * MiB + 832 * 1024, WS_CST = 24 * MiB + 256 * 1024, WS_ABUF = 27 * MiB, WS_CH = 61 * MiB, WS_G1 = 95 * MiB,
                 WS_QKV = 129 * MiB, WS_ATTN = 231 * MiB;
constexpr size_t WS_U = WS_ABUF, WS_Z = WS_CH, WS_W = WS_G1, WS_O = WS_QKV;
constexpr size_t OUT_Y = 0, OUT_CAP = 17825792, OUT_CBP = 17842176, OUT_SSP = 17915904, OUT_CAS = 18964480, OUT_CBS = 19226624, OUT_SSS = 20406272;
constexpr int LDS_BYTES = 72192;
constexpr float ALPHA_F = 1.41421356237309515f;

struct Params {
  const float *x_p, *x_s, *st_conv_a, *st_conv_b, *st_ssm, *c_p, *c_s, *w_mod, *b_mod, *ln_g, *ln_b, *wa_in, *wa_conv, *wa_out, *wb_in, *wb_conv,
      *wb_a_log, *wb_dt_bias, *wb_norm, *wb_out;
  float* out;
  char* ws;
};

typedef float f32x2v __attribute__((ext_vector_type(2)));
typedef __bf16 bf16x2v __attribute__((ext_vector_type(2)));
DI unsigned pk2(float lo, float hi) { f32x2v v = {lo, hi}; bf16x2v b = __builtin_convertvector(v, bf16x2v); return __builtin_bit_cast(unsigned, b); }
DI unsigned f2bf(float x) { __bf16 b = (__bf16)x; return (unsigned)__builtin_bit_cast(unsigned short, b); }
DI float bflo(unsigned u) { return __uint_as_float(u << 16); }
DI float bfhi(unsigned u) { return __uint_as_float(u & 0xffff0000u); }
DI float bf2f(bf16_t v) { return __uint_as_float(((unsigned)v) << 16); }
DI float silu(float x) { return x * __builtin_amdgcn_rcpf(1.f + __expf(-x)); }
DI int otid() { int t = threadIdx.x; asm volatile("" : "+v"(t)); return t; }
DI int rowi(int i, int lane) { return (i & 3) + 8 * (i >> 2) + 4 * (lane >> 5); }
DI int bidx(int row) { return row < MP ? (row >> 11) : 8 + ((row - MP) >> 3); }
DI const float* xrow(const Params& p, int row) { return row < MP ? p.x_p + (size_t)row * 1024 : p.x_s + (size_t)(row - MP) * 1024; }
DI bf16x8 pack8(const f32x16& x, int s) {
  u32x4 r;
  r[0] = pk2(x[8 * s + 0], x[8 * s + 1]); r[1] = pk2(x[8 * s + 2], x[8 * s + 3]); r[2] = pk2(x[8 * s + 4], x[8 * s + 5]); r[3] = pk2(x[8 * s + 6], x[8 * s + 7]);
  return __builtin_bit_cast(bf16x8, r);
}


#define XB_TMO      128
#define XB_XCNT(j)  (256  + 64 * (j))
#define XB_XSUB(j)  (1280 + 64 * (j))
#define XB_XGEN(j)  (2304 + 64 * (j))
#define XB_TOP      3328
#define XB_TOPGEN   3392
#define XCD_BAR_WORDS 3456
#define XB_SPIN_CAP (1u << 18)
#define LAS __attribute__((address_space(3)))
DI unsigned xb_ld(unsigned* p) { return __hip_atomic_load(p, __ATOMIC_RELAXED, __HIP_MEMORY_SCOPE_AGENT); }
DI unsigned xb_add(unsigned* p, unsigned v) { return __hip_atomic_fetch_add(p, v, __ATOMIC_RELAXED, __HIP_MEMORY_SCOPE_AGENT); }
DI unsigned xb_xcc_id() { return (unsigned)__builtin_amdgcn_s_getreg((3 << 11) | 20) & 0xFu; }
#define XB_SPIN(cond, bar) do { unsigned _sp = 0; while (cond) { __builtin_amdgcn_s_sleep(1); \
    if ((++_sp & 255u) == 0u) { if (xb_ld(&(bar)[XB_TMO])) break; if (_sp > XB_SPIN_CAP) { atomicAdd(&(bar)[XB_TMO], 1u); break; } } } } while (0)
struct XcdBarrier { unsigned* bar; unsigned x; volatile LAS unsigned* st; };
DI XcdBarrier xcd_barrier_post(unsigned* bar, volatile LAS unsigned* st) {
  XcdBarrier b; b.bar = bar; b.x = xb_xcc_id(); b.st = st;
  if (threadIdx.x == 0) (void)xb_add(&bar[XB_XCNT(b.x)], 1u);
  return b;
}
DI void xcd_barrier_complete(unsigned* bar, unsigned x, unsigned& nloc, unsigned& nx) {
  const unsigned G = gridDim.x * gridDim.y * gridDim.z;
  unsigned sum, cnt, mine, sp = 0u;
  for (;;) {
    sum = 0u; cnt = 0u; mine = 0u;
#pragma unroll
    for (unsigned j = 0; j < 16; ++j) { const unsigned c = xb_ld(&bar[XB_XCNT(j)]); sum += c; cnt += (c > 0u) ? 1u : 0u; mine = (j == x) ? c : mine; }
    if (sum == G) break;
    __builtin_amdgcn_s_sleep(1);
    if ((++sp & 255u) == 0u) { if (xb_ld(&bar[XB_TMO])) break; if (sp > XB_SPIN_CAP) { atomicAdd(&bar[XB_TMO], 1u); break; } }
  }
  nloc = mine > 0u ? mine : 1u; nx = cnt > 0u ? cnt : 1u;
}
DI void xcd_barrier(const XcdBarrier& b) {
  asm volatile("s_waitcnt vmcnt(0)" ::: "memory");
  __syncthreads();
  if (threadIdx.x == 0) {
    unsigned* bar = b.bar;
    __builtin_amdgcn_s_waitcnt(0);
    unsigned nloc = b.st[0], nx = b.st[1];
    if (nloc == 0u) { xcd_barrier_complete(bar, b.x, nloc, nx); b.st[0] = nloc; b.st[1] = nx; }
    const unsigned old = xb_add(&bar[XB_XSUB(b.x)], 1u);
    const unsigned gen = old / nloc;
    if (old + 1u == (gen + 1u) * nloc) {
      __builtin_amdgcn_fence(__ATOMIC_RELEASE, "agent");
      asm volatile("s_waitcnt vmcnt(0)" ::: "memory");
      const unsigned og = xb_add(&bar[XB_TOP], 1u);
      const unsigned tg = og / nx;
      if (og + 1u == (tg + 1u) * nx) xb_add(&bar[XB_TOPGEN], 1u);
      else XB_SPIN(xb_ld(&bar[XB_TOPGEN]) == tg, bar);
      __builtin_amdgcn_fence(__ATOMIC_ACQUIRE, "agent");
      xb_add(&bar[XB_XGEN(b.x)], 1u);
      asm volatile("s_waitcnt vmcnt(0)" ::: "memory");
    } else {
      XB_SPIN(xb_ld(&bar[XB_XGEN(b.x)]) == gen, bar);
      __builtin_amdgcn_fence(__ATOMIC_ACQUIRE, "agent");
      asm volatile("s_waitcnt vmcnt(0)" ::: "memory");
    }
  }
  __syncthreads();
}
DI void lds_barrier() { asm volatile("s_waitcnt lgkmcnt(0)\n\ts_barrier" ::: "memory"); }

DI void phase0a(const Params& p) {
  float* CST = (float*)(p.ws + WS_CST);
  for (int idx = blockIdx.x * 256 + otid(); idx < 1024 * 160; idx += gridDim.x * 256) {
    const int k = idx / 160, r = idx - k * 160;
    float v = 0.f;
    if (r < 8) v = silu(p.c_p[r * 1024 + k]); else if (r < 136) v = silu(p.c_s[(r - 8) * 1024 + k]);
    CST[idx] = v;
  }
}
DI void phase0(const Params& p, char* smem) {
  float* MOD = (float*)(p.ws + WS_MOD);
  const float* CST = (const float*)(p.ws + WS_CST);
  const int nmod = gridDim.x >= 384 ? 192 : 0;
  const int tstep = gridDim.x - nmod;
  if (nmod == 0 || (int)blockIdx.x < nmod)
  for (int task = blockIdx.x; task < 192; task += gridDim.x) {
    int tid = threadIdx.x; asm volatile("" : "+v"(tid));
    {
      const int l = task / 96, cb = task % 96;
      const int lane = tid & 63, wave = tid >> 6;
      float* red = (float*)smem;
      __syncthreads();
      for (int i = tid; i < 160 * 32; i += 256) red[i] = 0.f;
      __syncthreads();
      f32x16 acc[5];
#pragma unroll
      for (int mt = 0; mt < 5; ++mt)
#pragma unroll
        for (int i = 0; i < 16; ++i) acc[mt][i] = 0.f;
      const float* wm = p.w_mod + (size_t)l * 1024 * 3072 + cb * 32 + (lane & 31) + (size_t)(wave * 256 + (lane >> 5)) * 3072;
      const float* ct = CST + (lane & 31) + (wave * 256 + (lane >> 5)) * 160;
      float bA[8], aA[8][5], bB[8], aB[8][5];
#define MOD_LOAD(bb, aa, g) { _Pragma("unroll") for (int u = 0; u < 8; ++u) { const int kk = 2 * ((g) * 8 + u); bb[u] = __builtin_nontemporal_load(wm + (size_t)kk * 3072); _Pragma("unroll") for (int mt = 0; mt < 5; ++mt) aa[u][mt] = ct[kk * 160 + mt * 32]; } }
#define MOD_COMP(bb, aa) { _Pragma("unroll") for (int u = 0; u < 8; ++u) { _Pragma("unroll") for (int mt = 0; mt < 5; ++mt) acc[mt] = __builtin_amdgcn_mfma_f32_32x32x2f32(aa[u][mt], bb[u], acc[mt], 0, 0, 0); } }
      MOD_LOAD(bA, aA, 0);
#pragma unroll 1
      for (int g = 0; g < 16; g += 2) {
        MOD_LOAD(bB, aB, g + 1);
        MOD_COMP(bA, aA);
        { const int g2 = g + 2 < 16 ? g + 2 : 15; MOD_LOAD(bA, aA, g2); }
        MOD_COMP(bB, aB);
      }
#pragma unroll
      for (int mt = 0; mt < 5; ++mt)
#pragma unroll
        for (int i = 0; i < 16; ++i) atomicAdd(&red[(mt * 32 + rowi(i, lane)) * 32 + (lane & 31)], acc[mt][i]);
      __syncthreads();
      {
        const int col = tid & 31;
        const float bm = p.b_mod[l * 3072 + cb * 32 + col];
        for (int r = tid >> 5; r < 136; r += 8) MOD[((size_t)l * 136 + r) * 3072 + cb * 32 + col] = red[r * 32 + col] + bm;
      }
    }
  }
  if ((int)blockIdx.x >= nmod) {
    {
      const int tid = threadIdx.x;
      const int TOT = (4096 + 1024 + 4224 + 1024) * 128;
      const int nthr = tstep * 256;
      for (int it0 = ((int)blockIdx.x - nmod) * 256 + tid; it0 < TOT; it0 += 2 * nthr) {
        float v[2][8]; bf16_t* dptr[2]; bool ok[2];
#pragma unroll
        for (int u = 0; u < 2; ++u) {
          int it = it0 + u * nthr; ok[u] = it < TOT; if (!ok[u]) it = it0;
          const float* src; int ldw, N, mode; bf16_t* dst;
          if (it < 4096 * 128) { src = p.wa_in; ldw = 4096; N = 4096; mode = 1; dst = (bf16_t*)(p.ws + WS_WT1); }
          else if (it < 5120 * 128) { it -= 4096 * 128; src = p.wa_out; ldw = 1024; N = 1024; mode = 0; dst = (bf16_t*)(p.ws + WS_WT2); }
          else if (it < 9344 * 128) { it -= 5120 * 128; src = p.wb_in; ldw = 4112; N = 4224; mode = 2; dst = (bf16_t*)(p.ws + WS_WT3); }
          else { it -= 9344 * 128; src = p.wb_out; ldw = 1024; N = 1024; mode = 0; dst = (bf16_t*)(p.ws + WS_WT4); }
          const int k8 = it / N, np = it - k8 * N;
          int sc = np;
          if (mode == 1) { const int nt128 = np >> 7, seg = (np >> 5) & 3, j = np & 31; sc = (seg == 0 ? 1024 : seg == 1 ? 2048 : seg == 2 ? 0 : 3072) + nt128 * 32 + j; }
          const bool valid = !(mode == 2 && np >= 4112);
          const float* sp = src + (size_t)(k8 * 8) * ldw + (valid ? sc : 0);
#pragma unroll
          for (int j = 0; j < 8; ++j) { const float x = __builtin_nontemporal_load(sp + (size_t)j * ldw); v[u][j] = valid ? x : 0.f; }
          dptr[u] = dst + ((size_t)((np >> 5) * 64 + (k8 >> 1)) * 64 + (np & 31) + 32 * (k8 & 1)) * 8;
        }
#pragma unroll
        for (int u = 0; u < 2; ++u) if (ok[u]) {
          u32x4 o; o[0] = pk2(v[u][0], v[u][1]); o[1] = pk2(v[u][2], v[u][3]); o[2] = pk2(v[u][4], v[u][5]); o[3] = pk2(v[u][6], v[u][7]);
          *(u32x4*)dptr[u] = o;
        }
      }
    }
  }
}

DI void phase1(const Params& p) {
  const float* MOD = (const float*)(p.ws + WS_MOD);
  bf16_t* AB = (bf16_t*)(p.ws + WS_ABUF);
  for (int i = blockIdx.x * 256 + otid(); i < MTOT * 128; i += gridDim.x * 256) {
    const int row = i >> 7, c8 = (i & 127) * 8;
    const float* xr = xrow(p, row) + c8;
    const float* md = MOD + (size_t)bidx(row) * 3072 + c8;
    const f32x4 x0 = __builtin_nontemporal_load((const f32x4*)xr), x1 = __builtin_nontemporal_load((const f32x4*)(xr + 4));
    const f32x4 sh0 = *(const f32x4*)md, sh1 = *(const f32x4*)(md + 4), sc0 = *(const f32x4*)(md + 1024), sc1 = *(const f32x4*)(md + 1028);
    u32x4 o;
    o[0] = pk2(x0[0] * (1.f + sc0[0]) + sh0[0], x0[1] * (1.f + sc0[1]) + sh0[1]);
    o[1] = pk2(x0[2] * (1.f + sc0[2]) + sh0[2], x0[3] * (1.f + sc0[3]) + sh0[3]);
    o[2] = pk2(x1[0] * (1.f + sc1[0]) + sh1[0], x1[1] * (1.f + sc1[1]) + sh1[1]);
    o[3] = pk2(x1[2] * (1.f + sc1[2]) + sh1[2], x1[3] * (1.f + sc1[3]) + sh1[3]);
    *(u32x4*)(AB + (size_t)row * 1024 + c8) = o;
  }
}

template <int MI, class Epi>
DI void gemm_phase(const bf16_t* __restrict__ A, const bf16_t* __restrict__ Bt, const int ntN, char* smem, const Epi& epi) {
  constexpr int BM = 64 * MI;
  bf16_t* sA = (bf16_t*)smem;
  const int ntiles = (MTOT / BM) * ntN;
  for (int t = blockIdx.x; t < ntiles; t += gridDim.x) {
    const int tid = otid(), lane = tid & 63, wave = tid >> 6, wr = wave >> 1, wc = wave & 1;
    const int lrow = tid >> 3, lkc = (tid & 7) * 8;
    const int mt = t / ntN, nt = t - mt * ntN;
    const bf16_t* Ag = A + ((size_t)mt * BM + lrow) * 1024 + lkc;
    const bf16_t* Bf = Bt + (size_t)(nt * 4 + wc * 2) * 64 * 512 + lane * 8;
    f32x16 acc[MI][2];
#pragma unroll
    for (int mi = 0; mi < MI; ++mi)
#pragma unroll
      for (int nj = 0; nj < 2; ++nj)
#pragma unroll
        for (int i = 0; i < 16; ++i) acc[mi][nj][i] = 0.f;
    typename Epi::Pre pre;
    epi.prefetch(mt * BM + wr * (32 * MI), nt, wc, lane, pre);
    u32x4 ra[2 * MI];
    bf16x8 bfr[2][4];
#pragma unroll
    for (int q = 0; q < 2 * MI; ++q) ra[q] = *(const u32x4*)(Ag + (size_t)q * 32 * 1024);
#pragma unroll
    for (int nj = 0; nj < 2; ++nj)
#pragma unroll
      for (int ks = 0; ks < 4; ++ks) bfr[nj][ks] = *(const bf16x8*)(Bf + (size_t)(nj * 64 + ks) * 512);
    for (int kt = 0; kt < 16; ++kt) {
      lds_barrier();
#pragma unroll
      for (int q = 0; q < 2 * MI; ++q) *(u32x4*)(sA + (lrow + 32 * q) * 72 + lkc) = ra[q];
      lds_barrier();
      const int kn = kt < 15 ? kt + 1 : 15;
#pragma unroll
      for (int q = 0; q < 2 * MI; ++q) ra[q] = *(const u32x4*)(Ag + (size_t)q * 32 * 1024 + kn * 64);
      __builtin_amdgcn_sched_group_barrier(0x020, 2 * MI, 0);
      __builtin_amdgcn_s_setprio(2);
#pragma unroll
      for (int ks = 0; ks < 4; ++ks) {
        bf16x8 a[MI];
#pragma unroll
        for (int mi = 0; mi < MI; ++mi) a[mi] = *(const bf16x8*)(sA + (wr * (32 * MI) + mi * 32 + (lane & 31)) * 72 + ks * 16 + (lane >> 5) * 8);
#pragma unroll
        for (int mi = 0; mi < MI; ++mi)
#pragma unroll
          for (int nj = 0; nj < 2; ++nj) acc[mi][nj] = MFMA32(a[mi], bfr[nj][ks], acc[mi][nj]);
#pragma unroll
        for (int nj = 0; nj < 2; ++nj) bfr[nj][ks] = *(const bf16x8*)(Bf + (size_t)(nj * 64 + kn * 4 + ks) * 512);
      }
      __builtin_amdgcn_s_setprio(0);
    }
    epi(mt * BM + wr * (32 * MI), nt, wc, lane, acc, pre);
  }
}

DI unsigned pair_pk(float v0, float v1, int lane) {
  const bool odd = lane & 1;
  const float send = odd ? v0 : v1;
  const float recv = __builtin_bit_cast(float, __builtin_amdgcn_update_dpp(0, __builtin_bit_cast(int, send), 0xB1, 0xF, 0xF, true));
  return odd ? pk2(recv, v1) : pk2(v0, recv);
}
template <int MI> struct Epi1 {
  struct Pre {};
  DI void prefetch(int, int, int, int, Pre&) const {}
  bf16_t* CH; bf16_t* G1; float* out;
  template <bool TAIL> DI void body(int row0, int nt, int wc, int lane, const f32x16 (&acc)[MI][2]) const {
    const int ch = nt * 32 + (lane & 31);
    bf16_t* dst = (wc == 0 ? CH : G1) + (ch & ~1);
#pragma unroll
    for (int mi = 0; mi < MI; ++mi)
#pragma unroll
      for (int ip = 0; ip < 8; ++ip) {
        float v[2];
#pragma unroll
        for (int u = 0; u < 2; ++u) {
          const int i = 2 * ip + u;
          v[u] = wc == 0 ? acc[mi][0][i] * acc[mi][1][i] : acc[mi][0][i] * silu(acc[mi][1][i]);
          if (TAIL && wc == 0) {
            const int row = row0 + mi * 32 + rowi(i, lane);
            if (row < MP) { const int t = row & 2047; if (t >= 2046) out[OUT_CAP + (size_t)((row >> 11) * 2 + (t - 2046)) * 1024 + ch] = v[u]; }
            else { const int t = row & 7; if (t >= 6) out[OUT_CAS + (size_t)(((row - MP) >> 3) * 2 + (t - 6)) * 1024 + ch] = v[u]; }
          }
        }
        const int row = row0 + mi * 32 + rowi(2 * ip + (lane & 1), lane);
        *(unsigned*)(dst + (size_t)row * 1024) = pair_pk(v[0], v[1], lane);
      }
  }
  DI void operator()(int row0, int nt, int wc, int lane, const f32x16 (&acc)[MI][2], const Pre& pre) const {
    const bool tail = row0 >= MP || ((row0 + 32 * MI - 1) & 2047) >= 2046;
    if (tail) body<true>(row0, nt, wc, lane, acc); else body<false>(row0, nt, wc, lane, acc);
  }
};
template <int MI> struct Epi2 {
  Params p;
  struct Pre { float v[MI][2][16]; };
  DI void prefetch(int row0, int nt, int wc, int lane, Pre& pre) const {
    const float* base = xrow(p, row0 + 4 * (lane >> 5)) + nt * 128 + wc * 64 + (lane & 31);
#pragma unroll
    for (int mi = 0; mi < MI; ++mi)
#pragma unroll
      for (int i = 0; i < 16; ++i)
#pragma unroll
        for (int nj = 0; nj < 2; ++nj) pre.v[mi][nj][i] = __builtin_nontemporal_load(base + (mi * 32 + (i & 3) + 8 * (i >> 2)) * 1024 + nj * 32);
  }
  template <bool PROMPT> DI void body(int row0, int nt, int wc, int lane, const f32x16 (&acc)[MI][2], const Pre& pre) const {
    const float* MOD = (const float*)(p.ws + WS_MOD);
    const int c0 = nt * 128 + wc * 64 + (lane & 31);
    float g0 = 0.f, g1 = 0.f;
    if (PROMPT) { const float* gt = MOD + (size_t)(row0 >> 11) * 3072 + 2048 + c0; g0 = gt[0]; g1 = gt[32]; }
#pragma unroll
    for (int mi = 0; mi < MI; ++mi)
#pragma unroll
      for (int i = 0; i < 16; ++i) {
        const int row = row0 + mi * 32 + rowi(i, lane);
        if (!PROMPT) { const float* gt = MOD + (size_t)bidx(row) * 3072 + 2048 + c0; g0 = gt[0]; g1 = gt[32]; }
        float* yp = p.out + OUT_Y + (size_t)row * 1024 + c0;
        yp[0] = ALPHA_F * pre.v[mi][0][i] + g0 * acc[mi][0][i];
        yp[32] = ALPHA_F * pre.v[mi][1][i] + g1 * acc[mi][1][i];
      }
  }
  DI void operator()(int row0, int nt, int wc, int lane, const f32x16 (&acc)[MI][2], const Pre& pre) const {
    if (row0 < MP) body<true>(row0, nt, wc, lane, acc, pre); else body<false>(row0, nt, wc, lane, acc, pre);
  }
};
template <int MI> struct Epi3 {
  Params p;
  struct Pre {};
  DI void prefetch(int, int, int, int, Pre&) const {}
  template <bool TAIL> DI void body(int row0, int nt, int wc, int lane, const f32x16 (&acc)[MI][2]) const {
    bf16_t* QKV = (bf16_t*)(p.ws + WS_QKV); bf16_t* Z = (bf16_t*)(p.ws + WS_Z); float* BA = (float*)(p.ws + WS_BA);
    if (nt < 32) {
#pragma unroll
      for (int nj = 0; nj < 2; ++nj) {
        const int col = nt * 128 + wc * 64 + nj * 32 + (lane & 31);
        bf16_t* dst = nt < 24 ? QKV + (col & ~1) : Z + ((col - 3072) & ~1);
        const int ld = nt < 24 ? 3072 : 1024;
#pragma unroll
        for (int mi = 0; mi < MI; ++mi)
#pragma unroll
          for (int ip = 0; ip < 8; ++ip) {
            if (TAIL && nt < 24) {
#pragma unroll
              for (int u = 0; u < 2; ++u) {
                const int row = row0 + mi * 32 + rowi(2 * ip + u, lane);
                const float v = acc[mi][nj][2 * ip + u];
                if (row < MP) { const int t = row & 2047; if (t >= 2045) p.out[OUT_CBP + (size_t)((row >> 11) * 3 + (t - 2045)) * 3072 + col] = v; }
                else { const int t = row & 7; if (t >= 5) p.out[OUT_CBS + (size_t)(((row - MP) >> 3) * 3 + (t - 5)) * 3072 + col] = v; }
              }
            }
            const int row = row0 + mi * 32 + rowi(2 * ip + (lane & 1), lane);
            *(unsigned*)(dst + (size_t)row * ld) = pair_pk(acc[mi][nj][2 * ip], acc[mi][nj][2 * ip + 1], lane);
          }
      }
    } else if (wc == 0 && (lane & 31) < 16) {
#pragma unroll
      for (int mi = 0; mi < MI; ++mi)
#pragma unroll
        for (int i = 0; i < 16; ++i) BA[(size_t)(row0 + mi * 32 + rowi(i, lane)) * 16 + (lane & 31)] = acc[mi][0][i];
    }
  }
  DI void operator()(int row0, int nt, int wc, int lane, const f32x16 (&acc)[MI][2], const Pre& pre) const {
    const bool tail = row0 >= MP || ((row0 + 32 * MI - 1) & 2047) >= 2045;
    if (tail) body<true>(row0, nt, wc, lane, acc); else body<false>(row0, nt, wc, lane, acc);
  }
};
template <int MI> struct Epi4 {
  Params p;
  struct Pre { float v[MI][2][16]; };
  DI void prefetch(int row0, int nt, int wc, int lane, Pre& pre) const {
    const float* base = p.out + OUT_Y + (size_t)(row0 + 4 * (lane >> 5)) * 1024 + nt * 128 + wc * 64 + (lane & 31);
#pragma unroll
    for (int mi = 0; mi < MI; ++mi)
#pragma unroll
      for (int i = 0; i < 16; ++i)
#pragma unroll
        for (int nj = 0; nj < 2; ++nj) pre.v[mi][nj][i] = __builtin_nontemporal_load(base + (mi * 32 + (i & 3) + 8 * (i >> 2)) * 1024 + nj * 32);
  }
  template <bool PROMPT> DI void body(int row0, int nt, int wc, int lane, const f32x16 (&acc)[MI][2], const Pre& pre) const {
    const float* MOD = (const float*)(p.ws + WS_MOD) + (size_t)136 * 3072;
    const float* ST = (const float*)(p.ws + WS_STATS);
    const int c0 = nt * 128 + wc * 64 + (lane & 31);
    const float lg0 = p.ln_g[c0], lg1 = p.ln_g[c0 + 32], lb0 = p.ln_b[c0], lb1 = p.ln_b[c0 + 32];
    float g0 = 0.f, g1 = 0.f;
    if (PROMPT) { const float* gt = MOD + (size_t)(row0 >> 11) * 3072 + 2048 + c0; g0 = gt[0]; g1 = gt[32]; }
#pragma unroll
    for (int mi = 0; mi < MI; ++mi)
#pragma unroll
      for (int i = 0; i < 16; ++i) {
        const int row = row0 + mi * 32 + rowi(i, lane);
        const float mu = ST[row * 2], rstd = ST[row * 2 + 1];
        if (!PROMPT) { const float* gt = MOD + (size_t)bidx(row) * 3072 + 2048 + c0; g0 = gt[0]; g1 = gt[32]; }
        float* yp = p.out + OUT_Y + (size_t)row * 1024 + c0;
        yp[0] = ALPHA_F * ((pre.v[mi][0][i] - mu) * rstd * lg0 + lb0) + g0 * acc[mi][0][i];
        yp[32] = ALPHA_F * ((pre.v[mi][1][i] - mu) * rstd * lg1 + lb1) + g1 * acc[mi][1][i];
      }
  }
  DI void operator()(int row0, int nt, int wc, int lane, const f32x16 (&acc)[MI][2], const Pre& pre) const {
    if (row0 < MP) body<true>(row0, nt, wc, lane, acc, pre); else body<false>(row0, nt, wc, lane, acc, pre);
  }
};

DI void phase3(const Params& p) {
  const bf16_t* CH = (const bf16_t*)(p.ws + WS_CH); const bf16_t* G1 = (const bf16_t*)(p.ws + WS_G1);
  bf16_t* AB = (bf16_t*)(p.ws + WS_ABUF);
  for (int i = blockIdx.x * 256 + otid(); i < MTOT * 128; i += gridDim.x * 256) {
    const int row = i >> 7, c8 = (i & 127) * 8;
    const bool smp = row >= MP;
    const int t = smp ? (row & 7) : (row & 2047);
    float cur[8], p1[8], p2[8], g[8];
    { const u32x4 r = *(const u32x4*)(CH + (size_t)row * 1024 + c8);
#pragma unroll
      for (int e = 0; e < 4; ++e) { cur[2 * e] = bflo(r[e]); cur[2 * e + 1] = bfhi(r[e]); } }
    { const u32x4 r = __builtin_nontemporal_load((const u32x4*)(G1 + (size_t)row * 1024 + c8));
#pragma unroll
      for (int e = 0; e < 4; ++e) { g[2 * e] = bflo(r[e]); g[2 * e + 1] = bfhi(r[e]); } }
    if (t >= 1) { const u32x4 r = *(const u32x4*)(CH + (size_t)(row - 1) * 1024 + c8);
#pragma unroll
      for (int e = 0; e < 4; ++e) { p1[2 * e] = bflo(r[e]); p1[2 * e + 1] = bfhi(r[e]); } }
    else if (smp) { const float* b = p.st_conv_a + ((size_t)((row - MP) >> 3) * 2 + 1) * 1024 + c8;
#pragma unroll
      for (int e = 0; e < 8; ++e) p1[e] = b[e]; }
    else {
#pragma unroll
      for (int e = 0; e < 8; ++e) p1[e] = 0.f; }
    if (t >= 2) { const u32x4 r = *(const u32x4*)(CH + (size_t)(row - 2) * 1024 + c8);
#pragma unroll
      for (int e = 0; e < 4; ++e) { p2[2 * e] = bflo(r[e]); p2[2 * e + 1] = bfhi(r[e]); } }
    else if (smp) { const float* b = p.st_conv_a + ((size_t)((row - MP) >> 3) * 2 + t) * 1024 + c8;
#pragma unroll
      for (int e = 0; e < 8; ++e) p2[e] = b[e]; }
    else {
#pragma unroll
      for (int e = 0; e < 8; ++e) p2[e] = 0.f; }
    float o[8];
#pragma unroll
    for (int e = 0; e < 8; ++e) o[e] = g[e] * (p.wa_conv[c8 + e] * p2[e] + p.wa_conv[1024 + c8 + e] * p1[e] + p.wa_conv[2048 + c8 + e] * cur[e]);
    u32x4 ov; ov[0] = pk2(o[0], o[1]); ov[1] = pk2(o[2], o[3]); ov[2] = pk2(o[4], o[5]); ov[3] = pk2(o[6], o[7]);
    *(u32x4*)(AB + (size_t)row * 1024 + c8) = ov;
  }
}

template <int FINAL>
DI void ln_phase(const Params& p) {
  const int tid0 = otid();
  const int lane = tid0 & 63;
  const int gw = blockIdx.x * 4 + (tid0 >> 6), nw = gridDim.x * 4;
  const float* MOD1 = (const float*)(p.ws + WS_MOD) + (size_t)136 * 3072;
  float* ST = (float*)(p.ws + WS_STATS);
  bf16_t* AB = (bf16_t*)(p.ws + WS_ABUF);
  const float* lg = p.ln_g + (FINAL ? 1024 : 0); const float* lb = p.ln_b + (FINAL ? 1024 : 0);
  for (int row = gw; row < MTOT; row += nw) {
    float* yr = p.out + OUT_Y + (size_t)row * 1024;
    f32x4 v[4];
    float s = 0.f;
#pragma unroll
    for (int j = 0; j < 4; ++j) { v[j] = __builtin_nontemporal_load((const f32x4*)(yr + j * 256 + lane * 4)); s += v[j][0] + v[j][1] + v[j][2] + v[j][3]; }
#pragma unroll
    for (int o = 32; o >= 1; o >>= 1) s += __shfl_xor(s, o);
    const float mu = s * (1.f / 1024.f);
    float q = 0.f;
#pragma unroll
    for (int j = 0; j < 4; ++j)
#pragma unroll
      for (int e = 0; e < 4; ++e) { const float d = v[j][e] - mu; q += d * d; }
#pragma unroll
    for (int o = 32; o >= 1; o >>= 1) q += __shfl_xor(q, o);
    const float rstd = rsqrtf(q * (1.f / 1024.f) + 1e-5f);
    if (!FINAL && lane == 0) { ST[row * 2] = mu; ST[row * 2 + 1] = rstd; }
    const float* md = MOD1 + (size_t)bidx(row) * 3072;
#pragma unroll
    for (int j = 0; j < 4; ++j) {
      const int col = j * 256 + lane * 4;
      const f32x4 g4 = *(const f32x4*)(lg + col), b4 = *(const f32x4*)(lb + col);
      f32x4 x1;
#pragma unroll
      for (int e = 0; e < 4; ++e) x1[e] = (v[j][e] - mu) * rstd * g4[e] + b4[e];
      if (FINAL) { __builtin_nontemporal_store(x1, (f32x4*)(yr + col)); }
      else {
        const f32x4 sh = *(const f32x4*)(md + col), sc = *(const f32x4*)(md + 1024 + col);
        u32x2 o; o[0] = pk2(x1[0] * (1.f + sc[0]) + sh[0], x1[1] * (1.f + sc[1]) + sh[1]); o[1] = pk2(x1[2] * (1.f + sc[2]) + sh[2], x1[3] * (1.f + sc[3]) + sh[3]);
        *(u32x2*)(AB + (size_t)row * 1024 + col) = o;
      }
    }
  }
}

DI void gdn_chunk_local(const Params& p, char* smem0) {
  for (int task = blockIdx.x; task < 2048; task += gridDim.x) {
  int tid = threadIdx.x; asm volatile("" : "+v"(tid));
  int off0 = 0; asm volatile("" : "+v"(off0));
  char* smem = (char*)__builtin_assume_aligned(smem0 + (off0 & ~15), 16);
  const int lane = tid & 63, wave = __builtin_amdgcn_readfirstlane(tid >> 6);
  bf16_t* sq = (bf16_t*)smem;
  bf16_t* sk = sq + 64 * 136;
  bf16_t* sv = sk + 64 * 136;
  float* sAm = (float*)(smem + 3 * 17408);
  float* sc = (float*)(smem + 4 * 17408);
  float *sG = sc, *sBeta = sc + 64, *sRq = sc + 128, *sRk = sc + 192, *sSsq = sc + 256, *sSsk = sc + 320, *sBk = sc + 384, *sEg = sc + 448, *sKt = sc + 512;
  const bf16_t* QKV = (const bf16_t*)(p.ws + WS_QKV);
  const float* BA = (const float*)(p.ws + WS_BA);
  float* GL = (float*)(p.ws + WS_GL);
  bf16_t* Ug = (bf16_t*)(p.ws + WS_U); bf16_t* Wg = (bf16_t*)(p.ws + WS_W); bf16_t* ATT = (bf16_t*)(p.ws + WS_ATTN);
  bf16_t* QG = (bf16_t*)(p.out + OUT_SSS); bf16_t* KT = QG + (size_t)2048 * 8192;
  {
    const int n = task & 31, h = (task >> 5) & 7, b = task >> 8;
    const int row0 = b * 2048 + n * 64;
    {
      const int cg16 = tid & 15, rsub = tid >> 4;
      u32x4 raw[3][7];
#pragma unroll
      for (int seg = 0; seg < 3; ++seg)
#pragma unroll
        for (int r7 = 0; r7 < 7; ++r7) {
          const int ii = rsub * 4 - 3 + r7;
          if (n * 64 + ii >= 0) raw[seg][r7] = __builtin_nontemporal_load((const u32x4*)(QKV + (size_t)(row0 + ii) * 3072 + seg * 1024 + h * 128 + cg16 * 8));
          else { raw[seg][r7][0] = 0u; raw[seg][r7][1] = 0u; raw[seg][r7][2] = 0u; raw[seg][r7][3] = 0u; }
        }
#pragma unroll
      for (int seg = 0; seg < 3; ++seg) {
        const int colbase = seg * 1024 + h * 128 + cg16 * 8;
        float wt[4][8];
#pragma unroll
        for (int j = 0; j < 4; ++j) {
          const f32x4 w0 = *(const f32x4*)(p.wb_conv + j * 3072 + colbase), w1 = *(const f32x4*)(p.wb_conv + j * 3072 + colbase + 4);
#pragma unroll
          for (int e = 0; e < 4; ++e) { wt[j][e] = w0[e]; wt[j][4 + e] = w1[e]; }
        }
        bf16_t* dst = sq + seg * (64 * 136);
#pragma unroll
        for (int o4 = 0; o4 < 4; ++o4) {
          const int i = rsub * 4 + o4;
          float a8[8];
#pragma unroll
          for (int e = 0; e < 8; ++e) a8[e] = 0.f;
#pragma unroll
          for (int j = 0; j < 4; ++j) {
#pragma unroll
            for (int e = 0; e < 4; ++e) { a8[2 * e] += wt[j][2 * e] * bflo(raw[seg][o4 + j][e]); a8[2 * e + 1] += wt[j][2 * e + 1] * bfhi(raw[seg][o4 + j][e]); }
          }
          float ss = 0.f;
#pragma unroll
          for (int e = 0; e < 8; ++e) { a8[e] = silu(a8[e]); ss += a8[e] * a8[e]; }
          u32x4 o; o[0] = pk2(a8[0], a8[1]); o[1] = pk2(a8[2], a8[3]); o[2] = pk2(a8[4], a8[5]); o[3] = pk2(a8[6], a8[7]);
          *(u32x4*)(dst + i * 136 + cg16 * 8) = o;
          if (seg < 2) {
#pragma unroll
            for (int o2 = 8; o2 >= 1; o2 >>= 1) ss += __shfl_xor(ss, o2);
            if (cg16 == 0) sSsq[seg * 64 + i] = ss;
          }
        }
      }
    }
    __syncthreads();
    if (tid < 64) {
      const int row = row0 + tid;
      const float bb = BA[(size_t)row * 16 + h], aa = BA[(size_t)row * 16 + 8 + h];
      const float beta = 1.f / (1.f + expf(-bb));
      const float xx = aa + p.wb_dt_bias[h];
      const float sp = xx > 20.f ? xx : log1pf(expf(xx));
      const float g = -expf(p.wb_a_log[h]) * sp;
      float G = g;
#pragma unroll
      for (int off = 1; off < 64; off <<= 1) { const float tv = __shfl_up(G, off); if (lane >= off) G += tv; }
      const float Gl = __shfl(G, 63);
      const float rk = rsqrtf(sSsk[tid] + 1e-6f), rq = rsqrtf(sSsq[tid] + 1e-6f) * 0.08838834764831845f;
      const float eg = expf(G);
      sG[tid] = G; sBeta[tid] = beta; sRq[tid] = rq * eg; sRk[tid] = rk; sBk[tid] = rk * beta * eg; sEg[tid] = rq; sKt[tid] = rk * expf(Gl - G);
      if (tid == 63) GL[task] = eg;
    }
    __syncthreads();
    {
      bf16_t* qgo = QG + (size_t)task * 8192; bf16_t* kto = KT + (size_t)task * 8192;
#pragma unroll
      for (int c4 = 0; c4 < 4; ++c4) {
        const int o = tid + 256 * c4;
        {
          const int mt = o >> 9, s = (o >> 6) & 7, ln = o & 63, i = mt * 32 + (ln & 31), hh = ln >> 5;
          const u32x2 lo = *(const u32x2*)(sq + i * 136 + s * 16 + hh * 4), hi = *(const u32x2*)(sq + i * 136 + s * 16 + 8 + hh * 4);
          const float f = sRq[i];
          u32x4 ov; ov[0] = pk2(bflo(lo[0]) * f, bfhi(lo[0]) * f); ov[1] = pk2(bflo(lo[1]) * f, bfhi(lo[1]) * f);
          ov[2] = pk2(bflo(hi[0]) * f, bfhi(hi[0]) * f); ov[3] = pk2(bflo(hi[1]) * f, bfhi(hi[1]) * f);
          *(u32x4*)(qgo + (size_t)o * 8) = ov;
        }
        {
          const int mt = o >> 8, s = (o >> 6) & 3, ln = o & 63, m = mt * 32 + (ln & 31), hh = ln >> 5;
          float vv[8];
#pragma unroll
          for (int e = 0; e < 8; ++e) { const int j = s * 16 + (e >> 2) * 8 + hh * 4 + (e & 3); vv[e] = bf2f(sk[j * 136 + m]) * sKt[j]; }
          u32x4 ov; ov[0] = pk2(vv[0], vv[1]); ov[1] = pk2(vv[2], vv[3]); ov[2] = pk2(vv[4], vv[5]); ov[3] = pk2(vv[6], vv[7]);
          *(u32x4*)(kto + (size_t)o * 8) = ov;
        }
      }
    }
    const int mat = wave >> 1, gmi = wave & 1;
    f32x16 g2[2];
#pragma unroll
    for (int nj = 0; nj < 2; ++nj)
#pragma unroll
      for (int i = 0; i < 16; ++i) g2[nj][i] = 0.f;
    {
      const bf16_t* srcA = mat ? sq : sk;
#pragma unroll
      for (int ks = 0; ks < 8; ++ks) {
        const bf16x8 a = *(const bf16x8*)(srcA + (gmi * 32 + (lane & 31)) * 136 + ks * 16 + (lane >> 5) * 8);
#pragma unroll
        for (int nj = 0; nj < 2; ++nj) {
          const bf16x8 bb = *(const bf16x8*)(sk + (nj * 32 + (lane & 31)) * 136 + ks * 16 + (lane >> 5) * 8);
          g2[nj] = MFMA32(a, bb, g2[nj]);
        }
      }
    }
    __syncthreads();
#pragma unroll
    for (int nj = 0; nj < 2; ++nj)
#pragma unroll
      for (int r = 0; r < 16; ++r) {
        const int i = gmi * 32 + rowi(r, lane), j = nj * 32 + (lane & 31);
        const float dec = __expf(fminf(sG[i] - sG[j], 0.f));
        if (mat == 0) {
          sAm[i * 68 + j] = (i > j) ? sBeta[i] * sRk[i] * sRk[j] * dec * g2[nj][r] : 0.f;
        } else {
          const float val = (i >= j) ? sEg[i] * sRk[j] * dec * g2[nj][r] : 0.f;
          const int s = j >> 4, q = j & 15, e = (q >> 3) * 4 + (q & 3), hh = (q >> 2) & 1, ln = (i & 31) + 32 * hh;
          sq[((gmi * 4 + s) * 64 + ln) * 8 + e] = (bf16_t)f2bf(val);
        }
      }
    __syncthreads();
#pragma unroll
    for (int c = 0; c < 2; ++c) { const int o = tid + 256 * c; *(u32x4*)(ATT + (size_t)task * 4096 + (size_t)o * 8) = *(const u32x4*)(sq + o * 8); }
    typedef float f32x2 __attribute__((ext_vector_type(2)));
    f32x2 xv[32];
    {
      const bool isV = tid < 128;
      const bf16_t* src = isV ? (sv + tid) : (sk + (tid - 128));
      const float* scl = isV ? sBeta : sBk;
#pragma unroll
      for (int i = 0; i < 64; ++i) {
        f32x2 r0 = {bf2f(src[i * 136]) * scl[i], 0.f}, r1 = {0.f, 0.f};
#pragma unroll
        for (int m = 0; m < i / 2; ++m) {
          const f32x2 a2 = *(const f32x2*)(sAm + i * 68 + 2 * m);
          if (m & 1) r1 -= a2 * xv[m]; else r0 -= a2 * xv[m];
        }
        r0 += r1;
        float r = r0[0] + r0[1];
        if (i & 1) r -= sAm[i * 68 + i - 1] * xv[i / 2][0];
        xv[i / 2][i & 1] = r;
      }
    }
#define XS(i) xv[(i) >> 1][(i) & 1]
    __syncthreads();
    if (tid < 128) {
      const int s = tid >> 5, nn = tid & 31;
#pragma unroll
      for (int i = 0; i < 64; ++i) {
        const int mt = i >> 5, ii = i & 31, hh = (ii >> 2) & 1, r = (ii >> 3) * 4 + (ii & 3);
        sv[((s * 2 + mt) * 64 + nn + 32 * hh) * 16 + r] = (bf16_t)f2bf(XS(i));
      }
    } else {
      const int c = tid - 128, s = c >> 4, q = c & 15, e = (q >> 3) * 4 + (q & 3), hh = (q >> 2) & 1;
#pragma unroll
      for (int i = 0; i < 64; ++i) {
        const int mt = i >> 5;
        sk[((mt * 8 + s) * 64 + (i & 31) + 32 * hh) * 8 + e] = (bf16_t)f2bf(XS(i));
      }
    }
    __syncthreads();
#pragma unroll
    for (int c = 0; c < 4; ++c) {
      const int o = tid + 256 * c;
      *(u32x4*)(Ug + (size_t)task * 8192 + (size_t)o * 8) = *(const u32x4*)(sv + o * 8);
      *(u32x4*)(Wg + (size_t)task * 8192 + (size_t)o * 8) = *(const u32x4*)(sk + o * 8);
    }
    __syncthreads();
  }
  }
}

DI void gdn_scan(const Params& p, char* smem) {
  if (blockIdx.x >= 256) return;
  const int tid = otid(), lane = tid & 63, wave = __builtin_amdgcn_readfirstlane(tid >> 6);
  const int xcd = blockIdx.x & 7, yy = blockIdx.x >> 3;
  const int bh = xcd * 8 + (yy >> 2), s = yy & 3, h = bh & 7, b = bh >> 3;
  bf16x8* Sfrag = (bf16x8*)smem;
  bf16x8* Vfrag = Sfrag + 512;
  const bf16_t* Ug = (const bf16_t*)(p.ws + WS_U); const bf16_t* Wg = (const bf16_t*)(p.ws + WS_W); const bf16_t* ATT = (const bf16_t*)(p.ws + WS_ATTN);
  const bf16_t* QG = (const bf16_t*)(p.out + OUT_SSS); const bf16_t* KT = QG + (size_t)2048 * 8192;
  const float* GL = (const float*)(p.ws + WS_GL);
  bf16_t* O = (bf16_t*)(p.ws + WS_O);
  const size_t cbase = (size_t)(b * 8 + h) * 32;
  const bool isW = wave < 2; const int mi = wave & 1;
  f32x16 S;
#pragma unroll
  for (int i = 0; i < 16; ++i) S[i] = 0.f;
  { bf16x8 z; for (int e = 0; e < 8; ++e) z[e] = 0; for (int o = tid; o < 512; o += 256) Sfrag[o] = z; }
  const bf16_t* aBase = (isW ? Wg : QG) + cbase * 8192 + (size_t)(mi * 8) * 512 + lane * 8;
  const bf16_t* kBase = KT + cbase * 8192 + (size_t)(wave * 4) * 512 + lane * 8;
  const bf16_t* tBase = ATT + cbase * 4096 + (size_t)(mi * 4) * 512 + lane * 8;
  const bf16_t* uBase = Ug + cbase * 8192 + (size_t)((s * 2 + mi) * 64 + lane) * 16;
  struct Regs { bf16x8 afr[8], kfr[4], tfr[4]; u32x4 ur[2]; };
  const float glv = GL[cbase + (lane & 31)];
  Regs R0, R1;
  auto load_all = [&](Regs& R, int n) {
#pragma unroll
    for (int ks = 0; ks < 8; ++ks) R.afr[ks] = *(const bf16x8*)(aBase + (size_t)n * 8192 + ks * 512);
#pragma unroll
    for (int k4 = 0; k4 < 4; ++k4) { R.kfr[k4] = *(const bf16x8*)(kBase + (size_t)n * 8192 + k4 * 512); R.tfr[k4] = *(const bf16x8*)(tBase + (size_t)n * 4096 + k4 * 512); }
    R.ur[0] = __builtin_nontemporal_load((const u32x4*)(uBase + (size_t)n * 8192)); R.ur[1] = __builtin_nontemporal_load((const u32x4*)(uBase + (size_t)n * 8192 + 8));
  };
  load_all(R0, 0);
  load_all(R1, 1);
  __syncthreads();
  auto step = [&](Regs& R, const int n) {
    const int nn = n + 2 < 32 ? n + 2 : 31;
    f32x16 acc0, acc1;
#pragma unroll
    for (int i = 0; i < 16; ++i) { acc0[i] = 0.f; acc1[i] = 0.f; }
#pragma unroll
    for (int ks = 0; ks < 8; ks += 2) {
      acc0 = MFMA32(R.afr[ks], Sfrag[ks * 64 + lane], acc0);
      acc1 = MFMA32(R.afr[ks + 1], Sfrag[(ks + 1) * 64 + lane], acc1);
    }
#pragma unroll
    for (int i = 0; i < 16; ++i) acc0[i] += acc1[i];
#pragma unroll
    for (int ks = 0; ks < 8; ++ks) R.afr[ks] = *(const bf16x8*)(aBase + (size_t)nn * 8192 + ks * 512);
    if (isW) {
      f32x16 vn;
#pragma unroll
      for (int e = 0; e < 4; ++e) {
        vn[2 * e] = bflo(R.ur[0][e]) - acc0[2 * e]; vn[2 * e + 1] = bfhi(R.ur[0][e]) - acc0[2 * e + 1];
        vn[8 + 2 * e] = bflo(R.ur[1][e]) - acc0[8 + 2 * e]; vn[8 + 2 * e + 1] = bfhi(R.ur[1][e]) - acc0[8 + 2 * e + 1];
      }
      Vfrag[(2 * mi) * 64 + lane] = pack8(vn, 0);
      Vfrag[(2 * mi + 1) * 64 + lane] = pack8(vn, 1);
      R.ur[0] = __builtin_nontemporal_load((const u32x4*)(uBase + (size_t)nn * 8192)); R.ur[1] = __builtin_nontemporal_load((const u32x4*)(uBase + (size_t)nn * 8192 + 8));
    }
    lds_barrier();
    if (!isW) {
#pragma unroll
      for (int k4 = 0; k4 < 4; ++k4) acc0 = MFMA32(R.tfr[k4], Vfrag[k4 * 64 + lane], acc0);
      bf16_t* op = O + (size_t)(b * 2048 + n * 64 + mi * 32) * 1024 + h * 128 + s * 32 + (lane & 30);
#pragma unroll
      for (int ip = 0; ip < 8; ++ip) *(unsigned*)(op + (size_t)rowi(2 * ip + (lane & 1), lane) * 1024) = pair_pk(acc0[2 * ip], acc0[2 * ip + 1], lane);
#pragma unroll
      for (int k4 = 0; k4 < 4; ++k4) R.tfr[k4] = *(const bf16x8*)(tBase + (size_t)nn * 4096 + k4 * 512);
    }
    const float gl = __builtin_bit_cast(float, __builtin_amdgcn_readlane(__builtin_bit_cast(int, glv), n));
#pragma unroll
    for (int i = 0; i < 16; ++i) S[i] *= gl;
#pragma unroll
    for (int k4 = 0; k4 < 4; ++k4) S = MFMA32(R.kfr[k4], Vfrag[k4 * 64 + lane], S);
#pragma unroll
    for (int k4 = 0; k4 < 4; ++k4) R.kfr[k4] = *(const bf16x8*)(kBase + (size_t)nn * 8192 + k4 * 512);
    Sfrag[(2 * wave) * 64 + lane] = pack8(S, 0);
    Sfrag[(2 * wave + 1) * 64 + lane] = pack8(S, 1);
    lds_barrier();
  };
#pragma unroll 1
  for (int n = 0; n < 32; n += 2) { step(R0, n); step(R1, n + 1); }
  float* so = p.out + OUT_SSP + ((size_t)(b * 8 + h) * 128 + wave * 32) * 128 + s * 32 + (lane & 31);
#pragma unroll
  for (int r = 0; r < 16; ++r) so[(size_t)rowi(r, lane) * 128] = S[r];
}

DI void sample_task(const Params& p, char* smem, int task) {
  const int tid = otid(), lane = tid & 63, wave = tid >> 6;
  const int bs = task >> 3, h = task & 7;
  float* fq = (float*)smem; float* fk = fq + 1024; float* fv = fk + 1024; float* red = fv + 1024; float* ored = red + 2048; float* scal = ored + 2048;
  const bf16_t* QKV = (const bf16_t*)(p.ws + WS_QKV); const float* BA = (const float*)(p.ws + WS_BA);
  const bf16_t* Z = (const bf16_t*)(p.ws + WS_Z); bf16_t* AB = (bf16_t*)(p.ws + WS_ABUF);
  const int rowb = MP + bs * 8;
#pragma unroll
  for (int it = 0; it < 12; ++it) {
    const int idx = tid + 256 * it;
    const int tok = idx / 384, cc = idx - tok * 384, seg = cc >> 7, c = cc & 127, col = seg * 1024 + h * 128 + c;
    float acc = 0.f;
#pragma unroll
    for (int j = 0; j < 4; ++j) {
      const int tt = tok + j;
      const float xs = __builtin_nontemporal_load(p.st_conv_b + ((size_t)bs * 3 + (tt < 3 ? tt : 2)) * 3072 + col);
      const float xq = bf2f(QKV[(size_t)(rowb + (tt >= 3 ? tt - 3 : 0)) * 3072 + col]);
      acc += p.wb_conv[j * 3072 + col] * (tt < 3 ? xs : xq);
    }
    (seg == 0 ? fq : (seg == 1 ? fk : fv))[tok * 128 + c] = silu(acc);
  }
  if (tid < 8) {
    const int row = rowb + tid;
    const float bb = BA[(size_t)row * 16 + h], aa = BA[(size_t)row * 16 + 8 + h];
    const float xx = aa + p.wb_dt_bias[h];
    const float sp = xx > 20.f ? xx : log1pf(expf(xx));
    scal[tid] = 1.f / (1.f + expf(-bb));
    scal[8 + tid] = expf(-expf(p.wb_a_log[h]) * sp);
  }
  __syncthreads();
#pragma unroll
  for (int rr = 0; rr < 4; ++rr) {
    const int r16 = wave * 4 + rr;
    float* ptr = r16 < 8 ? fq + r16 * 128 : fk + (r16 - 8) * 128;
    const float a0 = ptr[lane], a1 = ptr[lane + 64];
    float ss = a0 * a0 + a1 * a1;
#pragma unroll
    for (int o = 32; o >= 1; o >>= 1) ss += __shfl_xor(ss, o);
    const float f = rsqrtf(ss + 1e-6f) * (r16 < 8 ? 0.08838834764831845f : 1.f);
    ptr[lane] = a0 * f; ptr[lane + 64] = a1 * f;
  }
  __syncthreads();
  const int vcol = tid & 127, kh = tid >> 7;
  float S[64];
  {
    const float* sp = p.st_ssm + (((size_t)bs * 8 + h) * 128 + kh * 64) * 128 + vcol;
#pragma unroll
    for (int kk = 0; kk < 64; ++kk) S[kk] = __builtin_nontemporal_load(sp + (size_t)kk * 128);
  }
#pragma unroll 1
  for (int t = 0; t < 8; ++t) {
    const float* kt = fk + t * 128 + kh * 64;
    const float* qt = fq + t * 128 + kh * 64;
    float part = 0.f;
#pragma unroll
    for (int kk = 0; kk < 64; ++kk) part += kt[kk] * S[kk];
    red[(t * 2 + kh) * 128 + vcol] = part;
    __syncthreads();
    const float kS = red[(t * 2) * 128 + vcol] + red[(t * 2 + 1) * 128 + vcol];
    const float a = scal[8 + t], be = scal[t];
    const float d = be * (fv[t * 128 + vcol] - a * kS);
    float op = 0.f;
#pragma unroll
    for (int kk = 0; kk < 64; ++kk) { S[kk] = a * S[kk] + kt[kk] * d; op += qt[kk] * S[kk]; }
    ored[(t * 2 + kh) * 128 + vcol] = op;
  }
  {
    float* so = p.out + OUT_SSS + (((size_t)bs * 8 + h) * 128 + kh * 64) * 128 + vcol;
#pragma unroll
    for (int kk = 0; kk < 64; ++kk) __builtin_nontemporal_store(S[kk], so + (size_t)kk * 128);
  }
  __syncthreads();
  {
    const int tok = tid >> 5, c4 = (tid & 31) * 4;
    float o[4]; float ss = 0.f;
#pragma unroll
    for (int e = 0; e < 4; ++e) { o[e] = ored[(tok * 2) * 128 + c4 + e] + ored[(tok * 2 + 1) * 128 + c4 + e]; ss += o[e] * o[e]; }
#pragma unroll
    for (int o2 = 16; o2 >= 1; o2 >>= 1) ss += __shfl_xor(ss, o2);
    const float rstd = rsqrtf(ss * (1.f / 128.f) + 1e-6f);
    const u32x2 zr = *(const u32x2*)(Z + (size_t)(rowb + tok) * 1024 + h * 128 + c4);
    const float z0 = bflo(zr[0]), z1 = bfhi(zr[0]), z2 = bflo(zr[1]), z3 = bfhi(zr[1]);
    u32x2 ov;
    ov[0] = pk2(o[0] * rstd * p.wb_norm[c4] * silu(z0), o[1] * rstd * p.wb_norm[c4 + 1] * silu(z1));
    ov[1] = pk2(o[2] * rstd * p.wb_norm[c4 + 2] * silu(z2), o[3] * rstd * p.wb_norm[c4 + 3] * silu(z3));
    *(u32x2*)(AB + (size_t)(rowb + tok) * 1024 + h * 128 + c4) = ov;
  }
  __syncthreads();
}

DI void phase9(const Params& p, char* smem) {
  const int tid9 = otid();
  const int lane = tid9 & 63, wave = tid9 >> 6;
  const bf16_t* O = (const bf16_t*)(p.ws + WS_O); const bf16_t* Z = (const bf16_t*)(p.ws + WS_Z); bf16_t* AB = (bf16_t*)(p.ws + WS_ABUF);
  for (int task = blockIdx.x; task < 2048; task += gridDim.x) {
    if (task < 1024) { sample_task(p, smem, task); continue; }
    const int r0 = (task - 1024) * 16 + wave * 4;
#pragma unroll
    for (int rr = 0; rr < 4; ++rr) {
      const int row = r0 + rr;
#pragma unroll
      for (int j = 0; j < 4; ++j) {
        const int col = j * 256 + lane * 4;
        const u32x2 orw = __builtin_nontemporal_load((const u32x2*)(O + (size_t)row * 1024 + col));
        f32x4 o4; o4[0] = bflo(orw[0]); o4[1] = bfhi(orw[0]); o4[2] = bflo(orw[1]); o4[3] = bfhi(orw[1]);
        float ss = o4[0] * o4[0] + o4[1] * o4[1] + o4[2] * o4[2] + o4[3] * o4[3];
#pragma unroll
        for (int o2 = 16; o2 >= 1; o2 >>= 1) ss += __shfl_xor(ss, o2);
        const float rstd = rsqrtf(ss * (1.f / 128.f) + 1e-6f);
        const u32x2 zr = __builtin_nontemporal_load((const u32x2*)(Z + (size_t)row * 1024 + col));
        const f32x4 nw = *(const f32x4*)(p.wb_norm + (col & 127));
        u32x2 ov;
        ov[0] = pk2(o4[0] * rstd * nw[0] * silu(bflo(zr[0])), o4[1] * rstd * nw[1] * silu(bfhi(zr[0])));
        ov[1] = pk2(o4[2] * rstd * nw[2] * silu(bflo(zr[1])), o4[3] * rstd * nw[3] * silu(bfhi(zr[1])));
        *(u32x2*)(AB + (size_t)row * 1024 + col) = ov;
      }
    }
  }
}

__global__ void __launch_bounds__(256, 2) fwd_megakernel(Params p) {
  extern __shared__ __attribute__((aligned(16))) char smem[];
  cg::grid_group grid = cg::this_grid();
  if (p.out == nullptr) grid.sync();
  __shared__ uint4 xb_words;
  if (threadIdx.x == 0) xb_words = make_uint4(0u, 0u, 0u, 0u);
  __syncthreads();
  XcdBarrier xb = xcd_barrier_post((unsigned*)(p.ws + WS_BAR), (volatile LAS unsigned*)&xb_words);
#define GSYNC() xcd_barrier(xb)
  phase0a(p);
  GSYNC();
  phase0(p, smem);
  GSYNC();
  phase1(p);
  GSYNC();
  { Epi1<4> e{(bf16_t*)(p.ws + WS_CH), (bf16_t*)(p.ws + WS_G1), p.out}; gemm_phase<4>((const bf16_t*)(p.ws + WS_ABUF), (const bf16_t*)(p.ws + WS_WT1), 32, smem, e); }
  GSYNC();
  phase3(p);
  GSYNC();
  { Epi2<2> e{p}; gemm_phase<2>((const bf16_t*)(p.ws + WS_ABUF), (const bf16_t*)(p.ws + WS_WT2), 8, smem, e); }
  GSYNC();
  ln_phase<0>(p);
  GSYNC();
  { Epi3<4> e{p}; gemm_phase<4>((const bf16_t*)(p.ws + WS_ABUF), (const bf16_t*)(p.ws + WS_WT3), 33, smem, e); }
  GSYNC();
  gdn_chunk_local(p, smem);
  GSYNC();
  gdn_scan(p, smem);
  GSYNC();
  phase9(p, smem);
  GSYNC();
  { Epi4<2> e{p}; gemm_phase<2>((const bf16_t*)(p.ws + WS_ABUF), (const bf16_t*)(p.ws + WS_WT4), 8, smem, e); }
  GSYNC();
  ln_phase<1>(p);
}

extern "C" void kernel_launch(void* const* d_in, const int* in_sizes, int n_in, void* d_out, int out_size, void* d_ws, size_t ws_size, hipStream_t stream) {
  static int grid_blocks = 0;
  if (!grid_blocks) {
    int dev = 0, cus = 0, per_cu = 0;
    hipGetDevice(&dev);
    hipDeviceGetAttribute(&cus, hipDeviceAttributeMultiprocessorCount, dev);
    hipFuncSetAttribute((const void*)fwd_megakernel, hipFuncAttributeMaxDynamicSharedMemorySize, LDS_BYTES);
    hipOccupancyMaxActiveBlocksPerMultiprocessor(&per_cu, (const void*)fwd_megakernel, 256, LDS_BYTES);
    if (per_cu < 1) per_cu = 1;
    if (per_cu > 2) per_cu = 2;
    grid_blocks = cus * per_cu;
    if (ws_size < 247 * MiB) fprintf(stderr, "kernel_launch: workspace too small: %zu\n", ws_size);
  }
  Params p{};
  const float** pp = (const float**)&p;
  for (int i = 0; i < 20; ++i) pp[i] = (const float*)d_in[i];
  p.out = (float*)d_out; p.ws = (char*)d_ws;
  hipMemsetAsync((char*)d_ws + WS_BAR, 0, XCD_BAR_WORDS * 4, stream);
  void* args[] = {&p};
  hipError_t e = hipLaunchCooperativeKernel((const void*)fwd_megakernel, dim3(grid_blocks), dim3(256), args, LDS_BYTES, stream);
  if (e != hipSuccess) fprintf(stderr, "cooperative launch failed: %s (grid %d)\n", hipGetErrorString(e), grid_blocks);
}
```
